# Optimizing an MI355X kernel written in HIP

```python
import jax, jax.numpy as jnp
from jax import lax
import numpy as np

D_MODEL = 4096
BATCH = 2
SEQ = 8192
DEPTH = 2

GRID_W = 64
CTX_LEN = 256
F_DIM = 1024
N_HEADS = 16
Q_LORA = 768
KV_LORA = 512
QK_NOPE = 128
QK_ROPE = 64
V_DIM = 128
QK_DIM = QK_NOPE + QK_ROPE
MLA_DIM = N_HEADS * V_DIM
ROPE_BASE = 10000.0
Q_BLOCK = 128
C_DIM = 1024
CONV_W = 31
N_BRANCH = 3
EPS = 1e-6

OFF_F = 0
OFF_F_GATE = OFF_F + F_DIM
OFF_Q = OFF_F_GATE + F_DIM
OFF_KV = OFF_Q + Q_LORA
OFF_KROPE = OFF_KV + KV_LORA
OFF_M_GATE = OFF_KROPE + QK_ROPE
OFF_GLU = OFF_M_GATE + MLA_DIM
OFF_C_GATE = OFF_GLU + 2 * C_DIM
OFF_MERGE = OFF_C_GATE + C_DIM
N_IN = OFF_MERGE + N_BRANCH * D_MODEL

kernel_name = 'hybrid_fourier_mla_conformer_dit_block'


def rms_norm(x, g):
    xf = x.astype(jnp.float32)
    y = xf * lax.rsqrt(jnp.mean(xf * xf, axis=-1, keepdims=True) + EPS)
    return (y * g.astype(jnp.float32)).astype(x.dtype)


def layer_norm(x, g, b):
    xf = x.astype(jnp.float32)
    mu = jnp.mean(xf, axis=-1, keepdims=True)
    d = xf - mu
    var = jnp.mean(d * d, axis=-1, keepdims=True)
    return (d * lax.rsqrt(var + EPS) * g.astype(jnp.float32) + b.astype(jnp.float32)).astype(x.dtype)


def rope_half(x, pos):
    half = x.shape[-1] // 2
    inv = ROPE_BASE ** (-jnp.arange(half, dtype=jnp.float32) / half)
    ang = pos.astype(jnp.float32)[:, None] * inv[None, :]
    cos = jnp.cos(ang)[:, None, :].astype(x.dtype)
    sin = jnp.sin(ang)[:, None, :].astype(x.dtype)
    x1, x2 = x[..., :half], x[..., half:]
    return jnp.concatenate([x1 * cos - x2 * sin, x1 * sin + x2 * cos], axis=-1)


def axial_rope(x, rows, cols):
    h = x.shape[-1] // 2
    return jnp.concatenate([rope_half(x[..., :h], rows), rope_half(x[..., h:], cols)], axis=-1)


def mla_queries(cq, q_a_norm, w_uq, q_norm, rows, cols):
    b, s, _ = cq.shape
    q = (rms_norm(cq, q_a_norm) @ w_uq).reshape(b, s, N_HEADS, QK_DIM)
    q = rms_norm(q, q_norm)
    if rows is None:
        return q
    return jnp.concatenate([q[..., :QK_NOPE], axial_rope(q[..., QK_NOPE:], rows, cols)], axis=-1)


def mla_keys_values(ckv, k_rope, kv_a_norm, w_ukv, k_norm, rows, cols):
    b, s, _ = ckv.shape
    kv = (rms_norm(ckv, kv_a_norm) @ w_ukv).reshape(b, s, N_HEADS, QK_NOPE + V_DIM)
    k_nope, v = kv[..., :QK_NOPE], kv[..., QK_NOPE:]
    k_r = jnp.broadcast_to(k_rope[:, :, None, :], (b, s, N_HEADS, QK_ROPE))
    k = rms_norm(jnp.concatenate([k_nope, k_r], axis=-1), k_norm)
    if rows is not None:
        k = jnp.concatenate([k[..., :QK_NOPE], axial_rope(k[..., QK_NOPE:], rows, cols)], axis=-1)
    return k, v


def attend(q, k, v):
    s = jnp.einsum('bqhd,bkhd->bhqk', q, k).astype(jnp.float32) * (QK_DIM ** -0.5)
    p = jax.nn.softmax(s, axis=-1).astype(v.dtype)
    return jnp.einsum('bhqk,bkhd->bqhd', p, v)


def blocked_attend(q, k, v):
    b, s, h, dh = q.shape
    nb = s // Q_BLOCK
    qb = q.reshape(b, nb, Q_BLOCK, h, dh).transpose(1, 0, 2, 3, 4)
    ob = lax.map(lambda blk: attend(blk, k, v), qb)
    return ob.transpose(1, 0, 2, 3, 4).reshape(b, s, h * V_DIM)


def fourier_mix(u, w_fnet):
    z = jnp.fft.fft2(u.astype(jnp.float32), axes=(1, 2), norm='ortho').real.astype(u.dtype)
    return z @ w_fnet


def conformer_conv(glu_in, conv_w, conv_b, cln_g, cln_b, w_pw2):
    a, g = jnp.split(glu_in, 2, axis=-1)
    u = a * jax.nn.sigmoid(g)
    u = lax.conv_general_dilated(u, conv_w[:, None, :], window_strides=(1,),
                                 padding=((CONV_W // 2, CONV_W // 2),),
                                 dimension_numbers=('NWC', 'WIO', 'NWC'),
                                 feature_group_count=C_DIM) + conv_b
    u = jax.nn.silu(layer_norm(u, cln_g, cln_b))
    return u @ w_pw2


def mix_and_merge(z, attn, w_fnet, conv_w, conv_b, cln_g, cln_b, w_pw2, w_br_f, w_br_m, w_br_c, w_out):
    y_f = fourier_mix(z[..., OFF_F:OFF_F_GATE], w_fnet) * jax.nn.silu(z[..., OFF_F_GATE:OFF_Q])
    y_m = attn * jax.nn.silu(z[..., OFF_M_GATE:OFF_GLU])
    y_c = conformer_conv(z[..., OFF_GLU:OFF_C_GATE], conv_w, conv_b, cln_g, cln_b, w_pw2) \
        * jax.nn.silu(z[..., OFF_C_GATE:OFF_MERGE])
    g_f, g_m, g_c = jnp.split(jax.nn.sigmoid(z[..., OFF_MERGE:]), N_BRANCH, axis=-1)
    merged = g_f * (y_f @ w_br_f) + g_m * (y_m @ w_br_m) + g_c * (y_c @ w_br_c)
    return merged @ w_out


def setup_inputs(seed: int = 0) -> dict:
    key = jax.random.key(seed)
    ks = jax.random.split(key, 24)
    L, D = DEPTH, D_MODEL
    nrm = lambda k, shape, scale: jax.random.normal(k, shape, dtype=jnp.float32) * scale
    gain = lambda k, shape: 1.0 + 0.05 * jax.random.normal(k, shape, dtype=jnp.float32)
    return {
        'x': nrm(ks[0], (BATCH, SEQ, D), 1.0),
        'c': nrm(ks[1], (BATCH, D), 1.0),
        'ctx': nrm(ks[2], (BATCH, CTX_LEN, D), 1.0),
        'c_ctx': nrm(ks[3], (D,), 1.0),
        'norm_g': gain(ks[4], (L, D)),
        'w_ada': nrm(ks[5], (L, D, 3 * D), 0.5 * D ** -0.5),
        'b_ada': nrm(ks[6], (L, 3 * D), 0.02),
        'w_in': nrm(ks[7], (L, D, N_IN), D ** -0.5),
        'q_a_norm': gain(ks[8], (L, Q_LORA)),
        'w_uq': nrm(ks[9], (L, Q_LORA, N_HEADS * QK_DIM), Q_LORA ** -0.5),
        'kv_a_norm': gain(ks[10], (L, KV_LORA)),
        'w_ukv': nrm(ks[11], (L, KV_LORA, N_HEADS * (QK_NOPE + V_DIM)), KV_LORA ** -0.5),
        'q_norm': gain(ks[12], (L, QK_DIM)),
        'k_norm': gain(ks[13], (L, QK_DIM)),
        'w_fnet': nrm(ks[14], (L, F_DIM, F_DIM), F_DIM ** -0.5),
        'conv_w': nrm(ks[15], (L, CONV_W, C_DIM), CONV_W ** -0.5),
        'conv_b': nrm(ks[16], (L, C_DIM), 0.02),
        'cln_g': gain(ks[17], (L, C_DIM)),
        'cln_b': nrm(ks[18], (L, C_DIM), 0.02),
        'w_pw2': nrm(ks[19], (L, C_DIM, C_DIM), C_DIM ** -0.5),
        'w_br_f': nrm(ks[20], (L, F_DIM, D), F_DIM ** -0.5),
        'w_br_m': nrm(ks[21], (L, MLA_DIM, D), MLA_DIM ** -0.5),
        'w_br_c': nrm(ks[22], (L, C_DIM, D), C_DIM ** -0.5),
        'w_out': nrm(ks[23], (L, D, D), D ** -0.5),
    }


def reference(x, c, ctx, c_ctx, norm_g, w_ada, b_ada, w_in, q_a_norm, w_uq, kv_a_norm, w_ukv,
              q_norm, k_norm, w_fnet, conv_w, conv_b, cln_g, cln_b, w_pw2, w_br_f, w_br_m,
              w_br_c, w_out):
    b, n_tok, _ = x.shape
    n_ctx = ctx.shape[1]
    n_rows = n_tok // GRID_W
    rows = jnp.repeat(jnp.arange(n_rows, dtype=jnp.int32), GRID_W)
    cols = jnp.tile(jnp.arange(GRID_W, dtype=jnp.int32), n_rows)
    xl, xc = x, ctx
    for l in range(DEPTH):
        last = l == DEPTH - 1
        shift_l, scale_l, gate_l = jnp.split(jax.nn.silu(c) @ w_ada[l] + b_ada[l], 3, axis=-1)
        n_mod_c = 2 if last else 3
        mod_c = jax.nn.silu(c_ctx) @ w_ada[l][:, :n_mod_c * D_MODEL] + b_ada[l][:n_mod_c * D_MODEL]
        shift_c, scale_c = mod_c[:D_MODEL], mod_c[D_MODEL:2 * D_MODEL]
        hl = rms_norm(xl, norm_g[l]) * (1 + scale_l[:, None, :]) + shift_l[:, None, :]
        hc = rms_norm(xc, norm_g[l]) * (1 + scale_c) + shift_c
        zl = hl @ w_in[l]
        if last:
            zkv_c = hc @ w_in[l][:, OFF_KV:OFF_M_GATE]
        else:
            zc = hc @ w_in[l]
            zkv_c = zc[..., OFF_KV:OFF_M_GATE]
        kc, vc = mla_keys_values(zkv_c[..., :KV_LORA], zkv_c[..., KV_LORA:], kv_a_norm[l],
                                 w_ukv[l], k_norm[l], None, None)
        kl, vl = mla_keys_values(zl[..., OFF_KV:OFF_KROPE], zl[..., OFF_KROPE:OFF_M_GATE],
                                 kv_a_norm[l], w_ukv[l], k_norm[l], rows, cols)
        ql = mla_queries(zl[..., OFF_Q:OFF_KV], q_a_norm[l], w_uq[l], q_norm[l], rows, cols)
        ol = blocked_attend(ql, jnp.concatenate([kc, kl], axis=1), jnp.concatenate([vc, vl], axis=1))
        branch_w = (w_fnet[l], conv_w[l], conv_b[l], cln_g[l], cln_b[l], w_pw2[l],
                    w_br_f[l], w_br_m[l], w_br_c[l], w_out[l])
        new_xl = xl + gate_l[:, None, :] * mix_and_merge(zl, ol, *branch_w)
        if not last:
            qc = mla_queries(zc[..., OFF_Q:OFF_KV], q_a_norm[l], w_uq[l], q_norm[l], None, None)
            oc = attend(qc, kc, vc).reshape(b, n_ctx, MLA_DIM)
            xc = xc + mod_c[2 * D_MODEL:] * mix_and_merge(zc, oc, *branch_w)
        xl = new_xl
    return xl
```

```cpp
#include <hip/hip_runtime.h>
#include <cstdio>
#include <cstdint>

#ifndef MK_PER_PHASE
#define MK_PER_PHASE 0
#endif

#define DUP_P0 1
#define DUP_B 1
#define DUP_F 1
#define DUP_EW 1
#define DUP_GS 1
#define ATT_DMA 1

#define LAS __attribute__((address_space(3)))
#define GAS __attribute__((address_space(1)))
typedef unsigned short bf16_t;
typedef short bf16x8 __attribute__((ext_vector_type(8)));
typedef short s16x4 __attribute__((ext_vector_type(4)));
typedef float f32x4 __attribute__((ext_vector_type(4)));
typedef float f32x2 __attribute__((ext_vector_type(2)));
typedef float f32x16 __attribute__((ext_vector_type(16)));
typedef unsigned u32x4 __attribute__((ext_vector_type(4)));
typedef unsigned u32x2 __attribute__((ext_vector_type(2)));

constexpr int DM = 4096, NB = 2, SEQ = 8192, CTX = 256, NL = 2;
constexpr int SB = SEQ + CTX;
constexpr int MROWS = NB * SB;
constexpr int TPB = SB / 256;
constexpr int NIN = 20800, NZ = 20992;
constexpr int ZC_F = 0, ZC_FG = 1024, ZC_Q = 2048, ZC_KV = 2816, ZC_KR = 3328, ZC_MG = 3584, ZC_GA = 5632, ZC_GG = 6656, ZC_CG = 7680,
              ZC_MF = 8704, ZC_MM = 12800, ZC_MC = 16896;
constexpr int NH = 16, DQK = 192, DNOPE = 128, DROPE = 64, DVH = 128, QLORA = 768, KVLORA = 512;
constexpr int FD = 1024, CD = 1024, MLA = 2048, CONVW = 31;
constexpr float EPS = 1e-6f;
constexpr int NWAVES = 8, NTHR = 512;

constexpr size_t al256(size_t x) { return (x + 255) & ~size_t(255); }
constexpr size_t MiB = size_t(1) << 20;
constexpr size_t WS_CTL = 0;
constexpr size_t WS_MOD = 1 * MiB;
constexpr size_t WS_V2 = WS_MOD + al256(size_t(2) * 3 * 12288 * 4);
constexpr size_t ZERO_BYTES = 2 * MiB;
constexpr size_t WS_SPEC = 2 * MiB;
constexpr size_t WS_ROPE = WS_SPEC + 32768;
constexpr size_t WS_CS256 = WS_ROPE + 16384;
constexpr size_t WS_CS = al256(WS_CS256 + 262144);
constexpr size_t WS_COS = WS_CS + 4 * MiB;
constexpr size_t WS_SIN = WS_COS + 32 * MiB;
constexpr size_t WS_W = WS_SIN + 32 * MiB;
constexpr size_t LW_IN = 0, LW_UQ = LW_IN + size_t(NZ) * DM * 2, LW_UKV = LW_UQ + size_t(3072) * 768 * 2, LW_FN = LW_UKV + size_t(4096) * 512 * 2,
                 LW_PW2 = LW_FN + size_t(1024) * 1024 * 2, LW_BR = LW_PW2 + size_t(1024) * 1024 * 2, LW_OUT = LW_BR + size_t(4096) * 4096 * 2,
                 LAYER_W = LW_OUT + size_t(4096) * 4096 * 2;
constexpr size_t WS_H = WS_W + 2 * LAYER_W;
constexpr size_t WS_Z = WS_H + size_t(MROWS) * DM * 2;
constexpr size_t WS_NCQ = WS_Z + size_t(MROWS) * NZ * 2;
constexpr size_t WS_NCKV = WS_NCQ + size_t(MROWS) * 768 * 2;
constexpr size_t WS_EO = WS_NCKV + size_t(MROWS) * 512 * 2;
constexpr size_t WS_CU = WS_EO + size_t(16384) * 1024 * 2;
constexpr size_t WS_QR = WS_CU + size_t(MROWS) * 1024 * 2;
constexpr size_t WS_KVR = WS_QR + size_t(MROWS) * 3072 * 2;
constexpr size_t WS_KN = WS_KVR + size_t(MROWS) * 4096 * 2;
constexpr size_t WS_Y = WS_KN + size_t(MROWS) * 3072 * 2;
constexpr size_t WS_ECOS = WS_Y + size_t(MROWS) * 4096 * 2;
constexpr size_t WS_TCT = WS_ECOS + size_t(2048) * 16384 * 2;
constexpr size_t WS_G12 = WS_TCT + size_t(2048) * 512 * 2;
constexpr size_t WS_ZF = WS_G12 + size_t(16384) * 1024 * 4;
constexpr size_t WS_MRG = WS_ZF + size_t(MROWS) * 1024 * 2;
constexpr size_t WS_XC1 = WS_MRG + size_t(MROWS) * 4096 * 2;
constexpr size_t WS_END = WS_XC1 + size_t(512) * 4096 * 4;

constexpr int CW_TMO = 0, CW_BAR = 4096;

constexpr int RING_BYTES = 131072, LDSCTL_OFF = RING_BYTES, MISC_OFF = LDSCTL_OFF + 320, LDS_BYTES = 147456;

__device__ __forceinline__ float bf_lo(unsigned w) { return __uint_as_float(w << 16); }
__device__ __forceinline__ float bf_hi(unsigned w) { return __uint_as_float(w & 0xffff0000u); }
__device__ __forceinline__ float bf2f(bf16_t b) { return __uint_as_float(((unsigned)b) << 16); }
__device__ __forceinline__ unsigned cvt_pk_bf16(float lo, float hi) { unsigned r; asm volatile("v_cvt_pk_bf16_f32 %0, %1, %2" : "=v"(r) : "v"(lo), "v"(hi)); return r; }
__device__ __forceinline__ bf16_t f2bf(float f) { return (bf16_t)(cvt_pk_bf16(f, 0.f) & 0xffffu); }
__device__ __forceinline__ float sigmoidf_(float x) { return __builtin_amdgcn_rcpf(1.0f + __builtin_amdgcn_exp2f(-1.4426950408889634f * x)); }
__device__ __forceinline__ float wave_sum(float v) {
#pragma unroll
    for (int o = 1; o < 64; o <<= 1) v += __shfl_xor(v, o);
    return v;
}
__device__ __forceinline__ int tid_fresh() { int t = threadIdx.x; asm volatile("" : "+v"(t)); return t; }
__device__ __forceinline__ void unpack8(const u32x4 w, float (&f)[8]) { f[0] = bf_lo(w.x); f[1] = bf_hi(w.x); f[2] = bf_lo(w.y); f[3] = bf_hi(w.y); f[4] = bf_lo(w.z); f[5] = bf_hi(w.z); f[6] = bf_lo(w.w); f[7] = bf_hi(w.w); }
__device__ __forceinline__ u32x4 pack8(const float (&f)[8]) { u32x4 w; w.x = cvt_pk_bf16(f[0], f[1]); w.y = cvt_pk_bf16(f[2], f[3]); w.z = cvt_pk_bf16(f[4], f[5]); w.w = cvt_pk_bf16(f[6], f[7]); return w; }
#define LDS_WAIT() asm volatile("s_waitcnt lgkmcnt(0)" ::: "memory")
#define VM_WAIT() asm volatile("s_waitcnt vmcnt(0)" ::: "memory")

namespace pg8 {
constexpr int BM = 256, BK = 64, HALF = 128, HTB = HALF * BK * 2, STAGE_BYTES = 8 * HTB, NXCD = 8, WGM = 8;
__host__ __device__ __forceinline__ int lds_byte(int r, int c) { const int st = (r >> 4) * 2 + (c >> 5), rr = r & 15, cc = c & 31, ob = rr * 64 + cc * 2; return st * 1024 + (ob ^ (((ob >> 9) & 1) << 5)); }
__host__ __device__ __forceinline__ void stage_rc(int b, int& R, int& C) { const int st = b / 1024, sb = b % 1024, swz = sb ^ (((sb >> 9) & 1) << 5); R = (st >> 1) * 16 + swz / 64; C = (st & 1) * 32 + (swz % 64) / 2; }
__host__ __device__ __forceinline__ int perm32(int rho) { const int n = rho >> 4, i = rho & 15; return 8 * (i >> 2) + 4 * n + (i & 3); }

struct Unit { const char* A; const char* B; int nt; int r0, c0; int aux; };

__device__ __forceinline__ bool order_tile(int i, int G, int c, int nM, int nN, int& pm, int& pn) {
    const int nwg = nM * nN; const long L = (long)i * G + c; if (L >= nwg) return false;
    int wgid = (int)L; { const int q = nwg / NXCD, r = nwg % NXCD, xcd = wgid % NXCD, off = wgid / NXCD; wgid = (xcd < r ? xcd * (q + 1) : r * (q + 1) + (xcd - r) * q) + off; }
    const int nig = WGM * nN, gid = wgid / nig, fm = gid * WGM, gsz = (nM - fm) < WGM ? (nM - fm) : WGM;
    pm = fm + ((wgid % nig) % gsz); pn = (wgid % nig) / gsz; return true;
}

template <class Epi, class Sched, bool ALIGN_EPI = true, bool SP2 = true>
__device__ __forceinline__ void gemm_phase(LAS unsigned char* lds, const Sched& S, const Epi& E, const int lda, const int ldb) {
    const int tid = tid_fresh(), wid = __builtin_amdgcn_readfirstlane(tid >> 6), lane = tid & 63, wr = wid >> 2, wc = wid & 3, fr = lane & 15, fq = lane >> 4;
    unsigned voffA[2], voffB[2];
#pragma unroll
    for (int i = 0; i < 2; ++i) { int R, C; stage_rc(tid * 16 + i * 8192, R, C); const int Rb = Epi::PERM ? ((R & ~31) + perm32(R & 31)) : R;
        voffA[i] = (unsigned)(R * lda + C) * 2u; voffB[i] = (unsigned)(Rb * ldb + C) * 2u; }
    const size_t kstep = (size_t)(BK * 2);
    const size_t hstepA = (size_t)HALF * lda * 2, hstepB = (size_t)HALF * ldb * 2;
    const unsigned ldsw = (unsigned)wid * 1024u;
    const int aoff = lds_byte(wr * 64 + fr, fq * 8), boff = lds_byte(wc * 32 + fr, fq * 8);
#define PG8_SA(b, h) (((b) * 2 + (h)) * HTB)
#define PG8_SB(b, h) ((4 + (b) * 2 + (h)) * HTB)
#define PG8_STAGE(bufoff, gbase, voff) do { _Pragma("unroll") for (int _i = 0; _i < 2; ++_i) \
        __builtin_amdgcn_global_load_lds((const unsigned*)((const char*)(gbase) + (voff)[_i]), (LAS unsigned*)(lds + (bufoff) + ldsw + _i * 8192), 16, 0, 0); } while (0)
#define PG8_LDA(dst, b, h) do { _Pragma("unroll") for (int m = 0; m < 4; ++m) _Pragma("unroll") for (int k = 0; k < 2; ++k) dst[m][k] = *(const LAS bf16x8*)(lds + PG8_SA(b, h) + aoff + m * 2048 + k * 1024); } while (0)
#define PG8_LDB(dst, b, h) do { _Pragma("unroll") for (int n = 0; n < 2; ++n) _Pragma("unroll") for (int k = 0; k < 2; ++k) dst[n][k] = *(const LAS bf16x8*)(lds + PG8_SB(b, h) + boff + n * 2048 + k * 1024); } while (0)
#define PG8_MMA(ai, bj, At, Bt) do { __builtin_amdgcn_s_setprio(1); _Pragma("unroll") for (int m = 0; m < 4; ++m) _Pragma("unroll") for (int n = 0; n < 2; ++n) _Pragma("unroll") for (int k = 0; k < 2; ++k) \
        acc[ai][bj][m][n] = __builtin_amdgcn_mfma_f32_16x16x32_bf16(Bt[n][k], At[m][k], acc[ai][bj][m][n], 0, 0, 0); __builtin_amdgcn_s_setprio(0); } while (0)
#define PG8_WAIT_V(n) asm volatile("s_waitcnt vmcnt(" #n ")" ::: "memory")
#define PG8_WAIT_L(n) asm volatile("s_waitcnt lgkmcnt(" #n ")" ::: "memory")
#define PG8_BAR __builtin_amdgcn_s_barrier()
#define PG8_SCHED __builtin_amdgcn_sched_barrier(0)
    Unit cur, nxt; int ui = 0;
    if (!S.next(0, cur)) return;
    f32x4 acc[2][2][4][2];
#pragma unroll
    for (int a = 0; a < 2; ++a)
#pragma unroll
        for (int b = 0; b < 2; ++b)
#pragma unroll
            for (int m = 0; m < 4; ++m)
#pragma unroll
                for (int n = 0; n < 2; ++n) acc[a][b][m][n] = (f32x4){0.f, 0.f, 0.f, 0.f};
    bf16x8 At[4][2], B0[2][2], B1[2][2];
    const char* cA = cur.A; const char* cB = cur.B;
    if constexpr (SP2) {
        PG8_STAGE(PG8_SB(0, 0), cB, voffB); PG8_STAGE(PG8_SB(0, 1), cB + hstepB, voffB); PG8_STAGE(PG8_SA(0, 0), cA, voffA); PG8_STAGE(PG8_SA(0, 1), cA + hstepA, voffA);
        if (wr == 1) PG8_BAR;
        PG8_WAIT_V(2); PG8_BAR;
        PG8_STAGE(PG8_SB(1, 0), cB + kstep, voffB); PG8_STAGE(PG8_SA(1, 0), cA + kstep, voffA); PG8_STAGE(PG8_SB(1, 1), cB + hstepB + kstep, voffB);
        PG8_WAIT_V(6); PG8_BAR;
    } else {
        PG8_STAGE(PG8_SB(0, 0), cB, voffB); PG8_STAGE(PG8_SA(0, 0), cA, voffA); PG8_STAGE(PG8_SB(0, 1), cB + hstepB, voffB); PG8_STAGE(PG8_SA(0, 1), cA + hstepA, voffA);
        if (wr == 1) PG8_BAR;
        PG8_WAIT_V(4); PG8_BAR;
        PG8_STAGE(PG8_SB(1, 0), cB + kstep, voffB); PG8_STAGE(PG8_SA(1, 0), cA + kstep, voffA); PG8_STAGE(PG8_SB(1, 1), cB + hstepB + kstep, voffB);
        PG8_WAIT_V(6); PG8_BAR;
    }
    for (;;) {
        const bool has_next = S.next(ui + 1, nxt);
        const char* nA = has_next ? nxt.A : cA; const char* nB = has_next ? nxt.B : cB;
        const int nt = cur.nt;
        for (int t = 0; t < nt; t += 2) {
            const bool last = (t == nt - 2);
            const char* a1 = cA + (size_t)(t + 1) * kstep;
            const char* a2 = last ? nA : cA + (size_t)(t + 2) * kstep; const char* b2 = last ? nB : cB + (size_t)(t + 2) * kstep;
            const char* a3 = a2 + kstep; const char* b3 = b2 + kstep;
            if constexpr (SP2) {
            PG8_LDB(B0, 0, 0); PG8_LDB(B1, 0, 1); PG8_SCHED; PG8_LDA(At, 0, 0); PG8_STAGE(PG8_SA(1, 1), a1 + hstepA, voffA);
            PG8_WAIT_V(8); PG8_WAIT_L(0); PG8_BAR; PG8_MMA(0, 0, At, B0); PG8_MMA(0, 1, At, B1); PG8_BAR; PG8_SCHED;
            PG8_LDA(At, 0, 1); PG8_STAGE(PG8_SB(0, 0), b2, voffB); PG8_STAGE(PG8_SB(0, 1), b2 + hstepB, voffB); PG8_STAGE(PG8_SA(0, 0), a2, voffA);
            PG8_WAIT_V(8); PG8_WAIT_L(0); PG8_BAR; PG8_MMA(1, 0, At, B0); PG8_MMA(1, 1, At, B1); PG8_BAR; PG8_SCHED;
            PG8_LDB(B0, 1, 0); PG8_LDB(B1, 1, 1); PG8_SCHED; PG8_LDA(At, 1, 0); PG8_STAGE(PG8_SA(0, 1), a2 + hstepA, voffA);
            PG8_WAIT_V(8); PG8_WAIT_L(0); PG8_BAR; PG8_MMA(0, 0, At, B0); PG8_MMA(0, 1, At, B1); PG8_BAR; PG8_SCHED;
            PG8_LDA(At, 1, 1); PG8_STAGE(PG8_SB(1, 0), b3, voffB); PG8_STAGE(PG8_SB(1, 1), b3 + hstepB, voffB); PG8_STAGE(PG8_SA(1, 0), a3, voffA);
            PG8_WAIT_V(8); PG8_WAIT_L(0); PG8_BAR; PG8_MMA(1, 0, At, B0); PG8_MMA(1, 1, At, B1); PG8_BAR; PG8_SCHED;
            } else {
            PG8_LDB(B0, 0, 0); PG8_SCHED; PG8_LDA(At, 0, 0); PG8_STAGE(PG8_SA(1, 1), a1 + hstepA, voffA);
            PG8_WAIT_L(8); PG8_BAR; PG8_WAIT_L(0); PG8_MMA(0, 0, At, B0); PG8_BAR; PG8_SCHED;
            PG8_LDB(B1, 0, 1); PG8_STAGE(PG8_SB(0, 0), b2, voffB);
            PG8_BAR; PG8_WAIT_L(0); PG8_MMA(0, 1, At, B1); PG8_BAR;
            PG8_LDA(At, 0, 1); PG8_STAGE(PG8_SA(0, 0), a2, voffA);
            PG8_BAR; PG8_WAIT_L(0); PG8_MMA(1, 0, At, B0); PG8_BAR; PG8_SCHED;
            PG8_STAGE(PG8_SB(0, 1), b2 + hstepB, voffB);
            PG8_WAIT_V(6); PG8_BAR; PG8_MMA(1, 1, At, B1); PG8_BAR;
            PG8_LDB(B0, 1, 0); PG8_SCHED; PG8_LDA(At, 1, 0); PG8_STAGE(PG8_SA(0, 1), a2 + hstepA, voffA);
            PG8_WAIT_L(8); PG8_BAR; PG8_WAIT_L(0); PG8_MMA(0, 0, At, B0); PG8_BAR; PG8_SCHED;
            PG8_LDB(B1, 1, 1); PG8_STAGE(PG8_SB(1, 0), b3, voffB);
            PG8_BAR; PG8_WAIT_L(0); PG8_MMA(0, 1, At, B1); PG8_BAR;
            PG8_LDA(At, 1, 1); PG8_STAGE(PG8_SA(1, 0), a3, voffA);
            PG8_BAR; PG8_WAIT_L(0); PG8_MMA(1, 0, At, B0); PG8_BAR; PG8_SCHED;
            PG8_STAGE(PG8_SB(1, 1), b3 + hstepB, voffB);
            PG8_WAIT_V(6); PG8_BAR; PG8_MMA(1, 1, At, B1); PG8_BAR;
            }
        }
        if constexpr (ALIGN_EPI) { if (wr == 0) PG8_BAR; }
        const bool keep = E(acc, cur, wr, wc, fr, fq);
        if (!has_next) break;
        if (!keep) {
#pragma unroll
        for (int a = 0; a < 2; ++a)
#pragma unroll
            for (int b = 0; b < 2; ++b)
#pragma unroll
                for (int m = 0; m < 4; ++m)
#pragma unroll
                    for (int n = 0; n < 2; ++n) acc[a][b][m][n] = (f32x4){0.f, 0.f, 0.f, 0.f};
        }
        cur = nxt; cA = nA; cB = nB; ++ui;
        if constexpr (ALIGN_EPI) { if (wr == 1) PG8_BAR; }
    }
    PG8_WAIT_V(0);
    if constexpr (!ALIGN_EPI) { if (wr == 0) PG8_BAR; }
    PG8_BAR;
#undef PG8_SA
#undef PG8_SB
#undef PG8_STAGE
#undef PG8_LDA
#undef PG8_LDB
#undef PG8_MMA
#undef PG8_WAIT_V
#undef PG8_WAIT_L
#undef PG8_BAR
#undef PG8_SCHED
}

struct TileSched {
    const char* A; const char* B; size_t lda2, ldb2; int nt, mode, nMv, nN, c0base, G, c;
    __device__ __forceinline__ void init(const void* A_, int lda, const void* B_, int ldb, int K, int mode_, int nN_, int c0base_, int G_, int c_) {
        A = (const char*)A_; B = (const char*)B_; lda2 = (size_t)lda * 2; ldb2 = (size_t)ldb * 2; nt = K / 64; mode = mode_; nMv = mode_ == 0 ? 66 : (mode_ == 1 ? 64 : 2); nN = nN_; c0base = c0base_; G = G_; c = c_; }
    __device__ __forceinline__ int units() const { return nMv * nN; }
    __device__ __forceinline__ bool next(int i, Unit& u) const {
        int vm, pn; if (!order_tile(i, G, c, nMv, nN, vm, pn)) return false;
        const int pm = mode == 0 ? vm : (mode == 1 ? vm + 1 + (vm >= 32 ? 1 : 0) : vm * TPB);
        u.A = A + (size_t)pm * 256 * lda2; u.B = B + (size_t)pn * 256 * ldb2; u.nt = nt; u.r0 = pm * 256; u.c0 = c0base + pn * 256; u.aux = 0; return true; }
};
struct MergeSched {
    const char* A; const char* B; int mode, nMv, G, c;
    __device__ __forceinline__ bool next(int i, Unit& u) const {
        const int ti = i / 3, k = i - ti * 3; int vm, pn; if (!order_tile(ti, G, c, nMv, 16, vm, pn)) return false;
        const int pm = mode == 0 ? vm : vm + 1 + (vm >= 32 ? 1 : 0);
        const int p = c % 6, s0 = p >> 1, r = p & 1, s1 = s0 == 0 ? (r ? 2 : 1) : (s0 == 1 ? (r ? 2 : 0) : (r ? 1 : 0)), s2 = 3 - s0 - s1;
        const int seg = k == 0 ? s0 : (k == 1 ? s1 : s2), nxt = k == 0 ? s1 : (k == 1 ? s2 : 3);
        const int koff = seg == 0 ? 0 : (seg == 1 ? 1024 : 3072);
        u.A = A + ((size_t)pm * 256 * 4096 + koff) * 2; u.B = B + ((size_t)pn * 256 * 4096 + koff) * 2; u.nt = seg == 1 ? 32 : 16; u.r0 = pm * 256; u.c0 = pn * 256; u.aux = seg * 4 + nxt; return true; }
};
struct CtxSplitSched {
    const char* A; const char* B; int merge, G, c;
    __device__ __forceinline__ bool next(int i, Unit& u) const {
        const long L = (long)i * G + c; if (L >= 256) return false;
        const int t = (int)L >> 3, ch = (int)L & 7, pmc = t >> 4, pn = t & 15, pm = pmc * TPB, koff = ch * 512;
        u.A = A + ((size_t)pm * 256 * 4096 + koff) * 2; u.B = B + ((size_t)pn * 256 * 4096 + koff) * 2; u.nt = 8; u.r0 = pmc * 256; u.c0 = pn * 256;
        u.aux = ch * 4 + (merge ? (ch < 2 ? 0 : (ch < 6 ? 1 : 2)) : 0); return true; }
};
struct CswSched {
    const char* WfnT; const char* CS; int G, c;
    __device__ __forceinline__ bool next(int i, Unit& u) const {
        const long L = (long)i * G + c; if (L >= 32) return false;
        const int pm = (int)L >> 3, pn = (int)L & 7;
        u.A = WfnT + (size_t)pm * 256 * 1024 * 2; u.B = CS + (size_t)pn * 256 * 1024 * 2; u.nt = 16; u.r0 = (pn >> 2) * 1024 + pm * 256; u.c0 = (pn & 3) * 256; u.aux = 0; return true; }
};
struct FchanSched {
    const char* CS; const char* EO; int G, c;
    __device__ __forceinline__ bool next(int i, Unit& u) const {
        const long L = (long)i * G + c; if (L >= 256) return false;
        const int j = (int)L >> 5, r = (int)L & 31, sn = (j >> 1) & 1, pmm = r >> 3, pns = r & 7;
        u.A = CS + (size_t)(sn * 1024 + pmm * 256) * 1024 * 2; u.B = EO + (size_t)(j * 2048 + pns * 256) * 1024 * 2; u.nt = 16;
        u.r0 = sn * 1024 + pmm * 256; u.c0 = j * 2048 + pns * 256; u.aux = 0; return true; }
};
struct FchanCtxSched {
    const char* CS; const char* Z; int G, c;
    __device__ __forceinline__ bool next(int i, Unit& u) const {
        const long L = (long)i * G + c; if (L >= 16) return false;
        const int b = (int)L >> 3, p8 = (int)L & 7;
        u.A = CS + (size_t)p8 * 256 * 1024 * 2; u.B = Z + ((size_t)b * SB * NZ + ZC_F) * 2; u.nt = 16;
        u.r0 = b * 1024 + (p8 & 3) * 256; u.c0 = (p8 >> 2) * 256; u.aux = 0; return true; }
};
struct FseqSched {
    const char* ws; int G, c;
    __device__ __forceinline__ bool next(int i, Unit& u) const {
        const long L = (long)i * G + c; if (L >= 256) return false;
        const int j = (int)L >> 5, r = (int)L & 31, a = j & 3, sn = a >> 1, pk = r >> 2, pmm = r & 3;
        u.A = ws + WS_COS + (size_t)a * (8 * MiB) + (size_t)pk * 256 * 2048 * 2; u.B = ws + WS_ECOS + ((size_t)(sn * 1024 + pmm * 256) * 16384 + (size_t)j * 2048) * 2; u.nt = 32;
        u.r0 = j * 2048 + pk * 256; u.c0 = pmm * 256; u.aux = 0; return true; }
};
struct FseqCtxSched {
    const char* CS256; const char* TCT; int G, c;
    __device__ __forceinline__ bool next(int i, Unit& u) const {
        const long L = (long)i * G + c; if (L >= 8) return false;
        const int b = (int)L >> 2, pmm = (int)L & 3;
        u.A = CS256; u.B = TCT + (size_t)(b * 1024 + pmm * 256) * 512 * 2; u.nt = 8; u.r0 = b * SB; u.c0 = pmm * 256; u.aux = 0; return true; }
};

__device__ __forceinline__ int zact_of_tile(int pn) {
    if (pn < 4) return 0; if (pn < 8) return 1; if (pn < 14) return 0; if (pn < 22) return 1; if (pn < 26) return 0; if (pn < 30) return 2; if (pn < 34) return 1; return 2; }

struct EpiZ {
    static constexpr bool PERM = true;
    bf16_t* Z;
    __device__ __forceinline__ bool operator()(f32x4 (&acc)[2][2][4][2], const Unit& u, int wr, int wc, int fr, int fq) const {
        const int kind = zact_of_tile(u.c0 >> 8);
        const int row0 = u.r0 + wr * 64 + fr, col0 = u.c0 + wc * 32 + 8 * fq;
#pragma unroll
        for (int ai = 0; ai < 2; ++ai)
#pragma unroll
            for (int m = 0; m < 4; ++m) { bf16_t* rowp = Z + (size_t)(row0 + ai * HALF + m * 16) * NZ + col0;
#pragma unroll
                for (int bj = 0; bj < 2; ++bj) { f32x4 v0 = acc[ai][bj][m][0], v1 = acc[ai][bj][m][1];
                    if (kind) {
#pragma unroll
                        for (int j = 0; j < 4; ++j) { const float s0 = sigmoidf_(v0[j]), s1 = sigmoidf_(v1[j]); v0[j] = kind == 1 ? v0[j] * s0 : s0; v1[j] = kind == 1 ? v1[j] * s1 : s1; } }
                    u32x4 w; w.x = cvt_pk_bf16(v0[0], v0[1]); w.y = cvt_pk_bf16(v0[2], v0[3]); w.z = cvt_pk_bf16(v1[0], v1[1]); w.w = cvt_pk_bf16(v1[2], v1[3]);
                    *(u32x4*)(rowp + bj * HALF) = w; } }
        return false;
    }
};
struct EpiBf16 {
    static constexpr bool PERM = true;
    bf16_t* O; int ldc; float scale;
    __device__ __forceinline__ bool operator()(f32x4 (&acc)[2][2][4][2], const Unit& u, int wr, int wc, int fr, int fq) const {
        const int row0 = u.r0 + wr * 64 + fr, col0 = u.c0 + wc * 32 + 8 * fq;
#pragma unroll
        for (int ai = 0; ai < 2; ++ai)
#pragma unroll
            for (int m = 0; m < 4; ++m) { bf16_t* rowp = O + (size_t)(row0 + ai * HALF + m * 16) * ldc + col0;
#pragma unroll
                for (int bj = 0; bj < 2; ++bj) { const f32x4 v0 = acc[ai][bj][m][0] * scale, v1 = acc[ai][bj][m][1] * scale;
                    u32x4 w; w.x = cvt_pk_bf16(v0[0], v0[1]); w.y = cvt_pk_bf16(v0[2], v0[3]); w.z = cvt_pk_bf16(v1[0], v1[1]); w.w = cvt_pk_bf16(v1[2], v1[3]);
                    *(u32x4*)(rowp + bj * HALF) = w; } }
        return false;
    }
};
struct EpiGate {
    static constexpr bool PERM = true;
    bf16_t* Y; const bf16_t* Z; int ycol, gcol; float scale;
    __device__ __forceinline__ bool operator()(f32x4 (&acc)[2][2][4][2], const Unit& u, int wr, int wc, int fr, int fq) const {
        const int row0 = u.r0 + wr * 64 + fr, col0 = u.c0 + wc * 32 + 8 * fq;
        u32x4 g[2][4][2];
#pragma unroll
        for (int ai = 0; ai < 2; ++ai)
#pragma unroll
            for (int m = 0; m < 4; ++m) { const size_t r = (size_t)(row0 + ai * HALF + m * 16);
#pragma unroll
                for (int bj = 0; bj < 2; ++bj) g[ai][m][bj] = *(const u32x4*)(Z + r * NZ + gcol + col0 + bj * HALF); }
        __builtin_amdgcn_sched_barrier(0);
#pragma unroll
        for (int ai = 0; ai < 2; ++ai)
#pragma unroll
            for (int m = 0; m < 4; ++m) { const size_t r = (size_t)(row0 + ai * HALF + m * 16);
#pragma unroll
                for (int bj = 0; bj < 2; ++bj) { const u32x4 gg = g[ai][m][bj];
                    const f32x4 v0 = acc[ai][bj][m][0] * scale, v1 = acc[ai][bj][m][1] * scale;
                    u32x4 w; w.x = cvt_pk_bf16(v0[0] * bf_lo(gg.x), v0[1] * bf_hi(gg.x)); w.y = cvt_pk_bf16(v0[2] * bf_lo(gg.y), v0[3] * bf_hi(gg.y));
                    w.z = cvt_pk_bf16(v1[0] * bf_lo(gg.z), v1[1] * bf_hi(gg.z)); w.w = cvt_pk_bf16(v1[2] * bf_lo(gg.w), v1[3] * bf_hi(gg.w));
                    *(u32x4*)(Y + r * 4096 + ycol + col0 + bj * HALF) = w; } }
        return false;
    }
};
struct EpiF32 {
    static constexpr bool PERM = false;
    float* C; int ldc;
    __device__ __forceinline__ bool operator()(f32x4 (&acc)[2][2][4][2], const Unit& u, int wr, int wc, int fr, int fq) const {
        const int row0 = u.r0 + wr * 64 + fr, col0 = u.c0 + wc * 32 + 4 * fq;
#pragma unroll
        for (int ai = 0; ai < 2; ++ai)
#pragma unroll
            for (int m = 0; m < 4; ++m) { float* rowp = C + (size_t)(row0 + ai * HALF + m * 16) * ldc + col0;
#pragma unroll
                for (int bj = 0; bj < 2; ++bj)
#pragma unroll
                    for (int n = 0; n < 2; ++n) *(f32x4*)(rowp + bj * HALF + n * 16) = acc[ai][bj][m][n]; }
        return false;
    }
};
struct EpiMerge {
    static constexpr bool PERM = true;
    bf16_t* O; const bf16_t* Z;
    __device__ __forceinline__ bool operator()(f32x4 (&acc)[2][2][4][2], const Unit& u, int wr, int wc, int fr, int fq) const {
        const int row0 = u.r0 + wr * 64 + fr, col0 = u.c0 + wc * 32 + 8 * fq; const int cur = u.aux >> 2, nxt = u.aux & 3; const bool last = nxt == 3;
        const int gnum = cur == 0 ? ZC_MF : (cur == 1 ? ZC_MM : ZC_MC), gden = nxt == 0 ? ZC_MF : (nxt == 1 ? ZC_MM : ZC_MC);
#pragma unroll
        for (int ai = 0; ai < 2; ++ai) {
            u32x4 gn[4][2], gd[4][2];
#pragma unroll
            for (int m = 0; m < 4; ++m)
#pragma unroll
                for (int bj = 0; bj < 2; ++bj) { const size_t r = (size_t)(row0 + ai * HALF + m * 16);
                    gn[m][bj] = *(const u32x4*)(Z + r * NZ + gnum + col0 + bj * HALF);
                    gd[m][bj] = last ? (u32x4){0x3f803f80u, 0x3f803f80u, 0x3f803f80u, 0x3f803f80u} : *(const u32x4*)(Z + r * NZ + gden + col0 + bj * HALF); }
            __builtin_amdgcn_sched_barrier(0);
#pragma unroll
            for (int m = 0; m < 4; ++m)
#pragma unroll
                for (int bj = 0; bj < 2; ++bj) { const size_t r = (size_t)(row0 + ai * HALF + m * 16);
                    const u32x4 a = gn[m][bj], d = gd[m][bj];
                    float f[8] = {bf_lo(a.x), bf_hi(a.x), bf_lo(a.y), bf_hi(a.y), bf_lo(a.z), bf_hi(a.z), bf_lo(a.w), bf_hi(a.w)};
                    if (!last) { const float dd[8] = {bf_lo(d.x), bf_hi(d.x), bf_lo(d.y), bf_hi(d.y), bf_lo(d.z), bf_hi(d.z), bf_lo(d.w), bf_hi(d.w)};
#pragma unroll
                        for (int j = 0; j < 8; ++j) f[j] = f[j] * __builtin_amdgcn_rcpf(fmaxf(dd[j], 1e-30f)); }
                    f32x4 v0 = acc[ai][bj][m][0], v1 = acc[ai][bj][m][1];
#pragma unroll
                    for (int j = 0; j < 4; ++j) { v0[j] *= f[j]; v1[j] *= f[4 + j]; }
                    if (!last) { acc[ai][bj][m][0] = v0; acc[ai][bj][m][1] = v1; }
                    else { u32x4 w; w.x = cvt_pk_bf16(v0[0], v0[1]); w.y = cvt_pk_bf16(v0[2], v0[3]); w.z = cvt_pk_bf16(v1[0], v1[1]); w.w = cvt_pk_bf16(v1[2], v1[3]);
                        *(u32x4*)(O + r * 4096 + col0 + bj * HALF) = w; } }
            __builtin_amdgcn_sched_barrier(0);
        }
        return !last;
    }
};
struct EpiMergePart {
    static constexpr bool PERM = true;
    float* PART; const bf16_t* Z;
    __device__ __forceinline__ bool operator()(f32x4 (&acc)[2][2][4][2], const Unit& u, int wr, int wc, int fr, int fq) const {
        const int ch = u.aux >> 2, seg = u.aux & 3, gcol = seg == 0 ? ZC_MF : (seg == 1 ? ZC_MM : ZC_MC);
        const int pmc = u.r0 >> 8; const size_t zrow0 = (size_t)pmc * SB;
        const int rl0 = wr * 64 + fr, col0 = u.c0 + wc * 32 + 8 * fq;
        float* P = PART + ((size_t)ch * 512 + u.r0) * 4096;
        u32x4 g[2][4][2];
#pragma unroll
        for (int ai = 0; ai < 2; ++ai)
#pragma unroll
            for (int m = 0; m < 4; ++m)
#pragma unroll
                for (int bj = 0; bj < 2; ++bj) g[ai][m][bj] = *(const u32x4*)(Z + (zrow0 + rl0 + ai * HALF + m * 16) * NZ + gcol + col0 + bj * HALF);
        __builtin_amdgcn_sched_barrier(0);
#pragma unroll
        for (int ai = 0; ai < 2; ++ai)
#pragma unroll
            for (int m = 0; m < 4; ++m)
#pragma unroll
                for (int bj = 0; bj < 2; ++bj) { const u32x4 gg = g[ai][m][bj]; const f32x4 v0 = acc[ai][bj][m][0], v1 = acc[ai][bj][m][1];
                    float* dst = P + (size_t)(rl0 + ai * HALF + m * 16) * 4096 + col0 + bj * HALF;
                    *(f32x4*)dst = (f32x4){v0[0] * bf_lo(gg.x), v0[1] * bf_hi(gg.x), v0[2] * bf_lo(gg.y), v0[3] * bf_hi(gg.y)};
                    *(f32x4*)(dst + 4) = (f32x4){v1[0] * bf_lo(gg.z), v1[1] * bf_hi(gg.z), v1[2] * bf_lo(gg.w), v1[3] * bf_hi(gg.w)}; }
        return false;
    }
};
struct EpiOutPart {
    static constexpr bool PERM = false;
    float* PART; const float* mod;
    __device__ __forceinline__ bool operator()(f32x4 (&acc)[2][2][4][2], const Unit& u, int wr, int wc, int fr, int fq) const {
        const int ch = u.aux >> 2; const float* gate = mod + (size_t)2 * 12288 + 2 * DM;
        const int rl0 = wr * 64 + fr, col0 = u.c0 + wc * 32 + 4 * fq;
        float* P = PART + ((size_t)ch * 512 + u.r0) * 4096;
#pragma unroll
        for (int bj = 0; bj < 2; ++bj)
#pragma unroll
            for (int n = 0; n < 2; ++n) { const f32x4 gv = *(const f32x4*)(gate + col0 + bj * HALF + n * 16);
#pragma unroll
                for (int ai = 0; ai < 2; ++ai)
#pragma unroll
                    for (int m = 0; m < 4; ++m) *(f32x4*)(P + (size_t)(rl0 + ai * HALF + m * 16) * 4096 + col0 + bj * HALF + n * 16) = gv * acc[ai][bj][m][n]; }
        return false;
    }
};
struct EpiOut {
    static constexpr bool PERM = false;
    const float* xl_old; const float* xc_old; float* xl_new; float* xc_new; const float* mod;
    __device__ __forceinline__ bool operator()(f32x4 (&acc)[2][2][4][2], const Unit& u, int wr, int wc, int fr, int fq) const {
        const int pm = u.r0 >> 8, b = pm / TPB, pt = pm - b * TPB; const bool isctx = pt == 0;
        const float* src = isctx ? xc_old + (size_t)b * CTX * DM : xl_old + ((size_t)b * SEQ + (size_t)(pt - 1) * 256) * DM;
        float* dst = isctx ? xc_new + (size_t)b * CTX * DM : xl_new + ((size_t)b * SEQ + (size_t)(pt - 1) * 256) * DM;
        const float* gate = mod + (size_t)(isctx ? 2 : b) * 12288 + 2 * DM;
        const int row0 = wr * 64 + fr, col0 = u.c0 + wc * 32 + 4 * fq;
        f32x4 gv[2][2];
#pragma unroll
        for (int bj = 0; bj < 2; ++bj)
#pragma unroll
            for (int n = 0; n < 2; ++n) gv[bj][n] = *(const f32x4*)(gate + col0 + bj * HALF + n * 16);
#pragma unroll
        for (int ai = 0; ai < 2; ++ai) {
            f32x4 xo[4][2][2];
#pragma unroll
            for (int m = 0; m < 4; ++m) { const size_t off = (size_t)(row0 + ai * HALF + m * 16) * DM + col0;
#pragma unroll
                for (int bj = 0; bj < 2; ++bj)
#pragma unroll
                    for (int n = 0; n < 2; ++n) xo[m][bj][n] = *(const f32x4*)(src + off + bj * HALF + n * 16); }
#pragma unroll
            for (int m = 0; m < 4; ++m)
#pragma unroll
                for (int bj = 0; bj < 2; ++bj)
#pragma unroll
                    for (int n = 0; n < 2; ++n) acc[ai][bj][m][n] = xo[m][bj][n] + gv[bj][n] * acc[ai][bj][m][n];
        }
#pragma unroll
        for (int ai = 0; ai < 2; ++ai)
#pragma unroll
            for (int m = 0; m < 4; ++m) { const size_t off = (size_t)(row0 + ai * HALF + m * 16) * DM + col0;
#pragma unroll
                for (int bj = 0; bj < 2; ++bj)
#pragma unroll
                    for (int n = 0; n < 2; ++n) *(f32x4*)(dst + off + bj * HALF + n * 16) = acc[ai][bj][m][n]; }
        return false;
    }
};
}

namespace att {
constexpr int NW = 8, QBLK = 32, KVBLK = 64;
constexpr float SCALE = 0.07216878364870322f;
constexpr float THR = 8.f;
constexpr int LDQ = 3072, LDK = 3072, LDV = 4096;
constexpr int SHM_V = KVBLK * DVH * 2, SHM_K = KVBLK * DQK * 2;
constexpr int SHM_QR = 2 * SHM_V + 2 * SHM_K + NW * 64 * 4;
constexpr int SHM_ATTN = SHM_QR + NW * 4096;
#ifndef ATT_SDEPTH
#define ATT_SDEPTH 1
#endif
constexpr int SDEPTH = ATT_SDEPTH;
#define KSWZ(row, colB) ((row) * 384 + ((colB) ^ ((((row) >> 1) & 7) << 4)))
#define SBAR() __builtin_amdgcn_sched_barrier(0)
__device__ __forceinline__ int crow(int r, int hi) { return (r & 3) + 8 * (r >> 2) + 4 * hi; }
__device__ __forceinline__ void partialSM(f32x16& p0, f32x16& p1, float& m_reg, float& mn, float& alpha) {
  constexpr float C = SCALE * 1.4426950408889634f;
  float pmax = p0[0];
#pragma unroll
  for (int r = 1; r < 16; ++r) pmax = fmaxf(pmax, p0[r]);
#pragma unroll
  for (int r = 0; r < 16; ++r) pmax = fmaxf(pmax, p1[r]);
  { auto rr = __builtin_amdgcn_permlane32_swap(__float_as_uint(pmax), __float_as_uint(pmax), false, false);
    pmax = fmaxf(__uint_as_float(rr[0]), __uint_as_float(rr[1])); }
  if (__builtin_expect(__all(pmax - m_reg <= THR / SCALE), 1)) { mn = m_reg; alpha = 1.f; }
  else { mn = fmaxf(m_reg, pmax); alpha = __builtin_amdgcn_exp2f((m_reg - mn) * C); m_reg = mn; }
  float mnC = -mn * C;
#pragma unroll
  for (int r = 0; r < 16; ++r) p0[r] = fmaf(p0[r], C, mnC);
#pragma unroll
  for (int r = 0; r < 16; ++r) p1[r] = fmaf(p1[r], C, mnC);
#pragma unroll
  for (int r = 0; r < 16; ++r) p0[r] = __builtin_amdgcn_exp2f(p0[r]);
}
__device__ __forceinline__ void partialSM_fix(f32x16& p0, f32x16& p1) {
#pragma unroll
  for (int r = 0; r < 16; ++r) p0[r] = __builtin_amdgcn_exp2f(p0[r]);
}
__device__ __forceinline__ void finishSM_fix(f32x16& p0, f32x16& p1, float& l_lane, bf16x8& pa0, bf16x8& pa1, bf16x8& pa2, bf16x8& pa3) {
#pragma unroll
  for (int r = 0; r < 16; ++r) p1[r] = __builtin_amdgcn_exp2f(p1[r]);
  float ps = 0;
#pragma unroll
  for (int r = 0; r < 16; ++r) ps += p0[r];
#pragma unroll
  for (int r = 0; r < 16; ++r) ps += p1[r];
  l_lane += ps;
#define PK4(P, BASE, OUT) do { unsigned a0 = cvt_pk_bf16(P[BASE + 0], P[BASE + 1]), a1 = cvt_pk_bf16(P[BASE + 2], P[BASE + 3]);   \
    unsigned b0 = cvt_pk_bf16(P[BASE + 4], P[BASE + 5]), b1 = cvt_pk_bf16(P[BASE + 6], P[BASE + 7]);                              \
    auto r0 = __builtin_amdgcn_permlane32_swap(a0, b0, false, false); auto r1 = __builtin_amdgcn_permlane32_swap(a1, b1, false, false); \
    u32x4 w = {r0[0], r1[0], r0[1], r1[1]}; OUT = *reinterpret_cast<bf16x8*>(&w); } while (0)
  PK4(p0, 0, pa0); PK4(p0, 8, pa1); PK4(p1, 0, pa2); PK4(p1, 8, pa3);
#undef PK4
}
__device__ __forceinline__ void finishSM(f32x16& p0, f32x16& p1, float alpha, float& l_reg, bf16x8& pa0, bf16x8& pa1, bf16x8& pa2, bf16x8& pa3) {
#pragma unroll
  for (int r = 0; r < 16; ++r) p1[r] = __builtin_amdgcn_exp2f(p1[r]);
  float ps = 0;
#pragma unroll
  for (int r = 0; r < 16; ++r) ps += p0[r];
#pragma unroll
  for (int r = 0; r < 16; ++r) ps += p1[r];
  { auto rr = __builtin_amdgcn_permlane32_swap(__float_as_uint(ps), __float_as_uint(ps), false, false);
    ps = __uint_as_float(rr[0]) + __uint_as_float(rr[1]); }
  l_reg = l_reg * alpha + ps;
#define PK4(P, BASE, OUT) do { unsigned a0 = cvt_pk_bf16(P[BASE + 0], P[BASE + 1]), a1 = cvt_pk_bf16(P[BASE + 2], P[BASE + 3]);   \
    unsigned b0 = cvt_pk_bf16(P[BASE + 4], P[BASE + 5]), b1 = cvt_pk_bf16(P[BASE + 6], P[BASE + 7]);                              \
    auto r0 = __builtin_amdgcn_permlane32_swap(a0, b0, false, false); auto r1 = __builtin_amdgcn_permlane32_swap(a1, b1, false, false); \
    u32x4 w = {r0[0], r1[0], r0[1], r1[1]}; OUT = *reinterpret_cast<bf16x8*>(&w); } while (0)
  PK4(p0, 0, pa0); PK4(p0, 8, pa1); PK4(p1, 0, pa2); PK4(p1, 8, pa3);
#undef PK4
}
__device__ __forceinline__ void qkt(f32x16& p0, f32x16& p1, const char* Ks, const bf16x8 (&qr)[8], const char* qrope, const int (&kb)[4]) {
  p0 = f32x16{}; p1 = f32x16{};
#define KLD(d, half) (*reinterpret_cast<const bf16x8*>(Ks + kb[(d) & 3] + ((d) >> 2) * 128 + (half) * (32 * 384)))
  bf16x8 c0 = KLD(0, 0), c1 = KLD(0, 1), cq = qr[0];
#pragma unroll
  for (int d0 = 0; d0 < 12; ++d0) {
    bf16x8 n0 = c0, n1 = c1, nq = cq;
    if (d0 < 11) { n0 = KLD(d0 + 1, 0); n1 = KLD(d0 + 1, 1); nq = (d0 + 1 < 8) ? qr[(d0 + 1 < 8) ? d0 + 1 : 0] : *reinterpret_cast<const bf16x8*>(qrope + (d0 + 1 - 8) * 1024); }
    __builtin_amdgcn_sched_group_barrier(0x100, 3, 0);
    p0 = __builtin_amdgcn_mfma_f32_32x32x16_bf16(c0, cq, p0, 0, 0, 0);
    p1 = __builtin_amdgcn_mfma_f32_32x32x16_bf16(c1, cq, p1, 0, 0, 0);
    __builtin_amdgcn_sched_group_barrier(0x008, 2, 0);
    c0 = n0; c1 = n1; cq = nq; }
#undef KLD
}
__device__ __forceinline__ int v_st(int k, int c) { const int kk = (k & ~0xC) | ((k & 4) << 1) | ((k & 8) >> 1); return ((kk >> 3) * 4 + (c >> 5)) * 512 + ((kk & 7) * 32 + (c & 31)) * 2; }
__device__ __forceinline__ int v_rd_base(int lane) { return ((lane & 3) << 3) | (((lane >> 2) & 3) << 6) | (((lane >> 4) & 1) << 5) | (((lane >> 5) & 1) << 8); }
constexpr int v_rd_off(int d0, int ks, int half) { return d0 * 512 + ks * 4096 + half * 2048; }
template <int OFF> __device__ __forceinline__ s16x4 tr_read(int vb) {
  s16x4 r; asm volatile("ds_read_b64_tr_b16 %0, %1 offset:%2" : "=&v"(r) : "v"(vb), "i"(OFF) : "memory"); return r;
}
template <int D0> __device__ __forceinline__ void pv_one(f32x16& od, int vb, bf16x8 pa0, bf16x8 pa1, bf16x8 pa2, bf16x8 pa3) {
  const s16x4 l0 = tr_read<v_rd_off(D0, 0, 0)>(vb), h0 = tr_read<v_rd_off(D0, 0, 1)>(vb), l1 = tr_read<v_rd_off(D0, 1, 0)>(vb), h1 = tr_read<v_rd_off(D0, 1, 1)>(vb);
  const s16x4 l2 = tr_read<v_rd_off(D0, 2, 0)>(vb), h2 = tr_read<v_rd_off(D0, 2, 1)>(vb), l3 = tr_read<v_rd_off(D0, 3, 0)>(vb), h3 = tr_read<v_rd_off(D0, 3, 1)>(vb);
  asm volatile("s_waitcnt lgkmcnt(0)" ::: "memory"); SBAR();
#define PK(L, H) (bf16x8){L[0], L[1], L[2], L[3], H[0], H[1], H[2], H[3]}
  od = __builtin_amdgcn_mfma_f32_32x32x16_bf16(pa0, PK(l0, h0), od, 0, 0, 0);
  od = __builtin_amdgcn_mfma_f32_32x32x16_bf16(pa1, PK(l1, h1), od, 0, 0, 0);
  od = __builtin_amdgcn_mfma_f32_32x32x16_bf16(pa2, PK(l2, h2), od, 0, 0, 0);
  od = __builtin_amdgcn_mfma_f32_32x32x16_bf16(pa3, PK(l3, h3), od, 0, 0, 0);
#undef PK
}
__device__ __forceinline__ void pv_d0(f32x16 (&o)[4], int vb, bf16x8 pa0, bf16x8 pa1, bf16x8 pa2, bf16x8 pa3) {
  pv_one<0>(o[0], vb, pa0, pa1, pa2, pa3); pv_one<1>(o[1], vb, pa0, pa1, pa2, pa3); pv_one<2>(o[2], vb, pa0, pa1, pa2, pa3); pv_one<3>(o[3], vb, pa0, pa1, pa2, pa3);
}

__device__ __forceinline__ void attn_unit(const bf16_t* __restrict__ Qb, const bf16_t* __restrict__ Kh, const bf16_t* __restrict__ Vh, int seq, char* lds,
                                          const bf16_t* __restrict__ gate, bf16_t* __restrict__ Yo) {
  const int tid = tid_fresh(), wid = tid >> 6, lane = tid & 63, r32 = lane & 31, hi = lane >> 5;
  char* V_lds = lds; char* K_lds = lds + 2 * SHM_V;
  float* ws = (float*)(lds + 2 * SHM_V + 2 * SHM_K) + wid * 64; float* li_l = ws; float* al_l = ws + 32;
  float m_reg = -1e30f, l_reg = 0; f32x16 o[4] = {}; bf16x8 qr[8];
  const bf16_t* Qw = Qb + (long)(wid * QBLK + r32) * LDQ + hi * 8;
  char* qrope = lds + SHM_QR + wid * 4096 + lane * 16;
  int kb[4];
#pragma unroll
  for (int d = 0; d < 4; ++d) kb[d] = r32 * 384 + (((d * 2 + hi) ^ ((r32 >> 1) & 7)) << 4);
#pragma unroll
  for (int d0 = 0; d0 < 8; ++d0) qr[d0] = *reinterpret_cast<const bf16x8*>(Qw + d0 * 16);
#pragma unroll
  for (int d0 = 8; d0 < 12; ++d0) *reinterpret_cast<bf16x8*>(qrope + (d0 - 8) * 1024) = *reinterpret_cast<const bf16x8*>(Qw + d0 * 16);
  const int sr = tid >> 4, sc = (tid & 15) * 8, vst0 = v_st(sr, sc), vst1 = v_st(32 + sr, sc);
  unsigned kvo[3], klo[3];
#pragma unroll
  for (int i = 0; i < 3; ++i) { const int q = tid + 512 * i, kr = q / 24, kc = q - kr * 24; kvo[i] = (unsigned)(kr * LDK + kc * 8) * 2u; klo[i] = (unsigned)KSWZ(kr, kc * 16); }
  const unsigned vvo0 = (unsigned)(sr * LDV + sc) * 2u, vvo1 = (unsigned)((32 + sr) * LDV + sc) * 2u;
  const int vb0 = (int)(uintptr_t)V_lds + v_rd_base(lane);
  struct { bf16x8 vs0, vs1, ks0, ks1, ks2; } sr_[SDEPTH];
#define SLOAD(i, k0) do { const char* Vt_ = (const char*)Vh + (size_t)(k0) * (LDV * 2); const char* Kt_ = (const char*)Kh + (size_t)(k0) * (LDK * 2); \
    sr_[i].vs0 = *reinterpret_cast<const bf16x8*>(Vt_ + vvo0); sr_[i].vs1 = *reinterpret_cast<const bf16x8*>(Vt_ + vvo1); \
    sr_[i].ks0 = *reinterpret_cast<const bf16x8*>(Kt_ + kvo[0]); sr_[i].ks1 = *reinterpret_cast<const bf16x8*>(Kt_ + kvo[1]); sr_[i].ks2 = *reinterpret_cast<const bf16x8*>(Kt_ + kvo[2]); } while (0)
#define SWRITE(b, i) do { *(bf16x8*)(V_lds + (b) * SHM_V + vst0) = sr_[i].vs0; *(bf16x8*)(V_lds + (b) * SHM_V + vst1) = sr_[i].vs1; \
    *(bf16x8*)(K_lds + (b) * SHM_K + klo[0]) = sr_[i].ks0; *(bf16x8*)(K_lds + (b) * SHM_K + klo[1]) = sr_[i].ks1; *(bf16x8*)(K_lds + (b) * SHM_K + klo[2]) = sr_[i].ks2; } while (0)
#define SWAIT() do { if constexpr (SDEPTH == 2) asm volatile("s_waitcnt vmcnt(5)" ::: "memory"); else asm volatile("s_waitcnt vmcnt(0)" ::: "memory"); } while (0)
#define RESC(a) do { if (__any((a) < 1.f)) { if (hi == 0) al_l[r32] = (a); asm volatile("s_waitcnt lgkmcnt(0)" ::: "memory"); \
    _Pragma("unroll") for (int d = 0; d < 4; ++d) _Pragma("unroll") for (int r = 0; r < 16; ++r) o[d][r] *= al_l[crow(r, hi)]; } } while (0)
  f32x16 pA0, pA1, pB0, pB1; float mnA, mnB, alA, alB; bf16x8 pa0, pa1, pa2, pa3; const int NT = seq / KVBLK;
  constexpr int SE = 0, SO = SDEPTH - 1;
  SLOAD(SE, 0); asm volatile("s_waitcnt vmcnt(0)" ::: "memory"); SWRITE(0, SE); __syncthreads();
  qkt(pA0, pA1, K_lds, qr, qrope, kb); partialSM(pA0, pA1, m_reg, mnA, alA);
  SLOAD(SO, KVBLK); if constexpr (SDEPTH == 2) { if (2 < NT) SLOAD(SE, 2 * KVBLK); }
  SWAIT(); SWRITE(1, SO); __syncthreads();
  for (int j = 1; j + 1 < NT; j += 2) {
    SBAR(); qkt(pB0, pB1, K_lds + SHM_K, qr, qrope, kb);
    finishSM(pA0, pA1, alA, l_reg, pa0, pa1, pa2, pa3); SBAR();
    SLOAD(SO, (j + SDEPTH) * KVBLK); SBAR();
    pv_d0(o, vb0, pa0, pa1, pa2, pa3); partialSM(pB0, pB1, m_reg, mnB, alB);
    __syncthreads(); SWAIT(); SWRITE(0, SE);
    RESC(alB); __syncthreads();
    SBAR(); qkt(pA0, pA1, K_lds, qr, qrope, kb);
    finishSM(pB0, pB1, alB, l_reg, pa0, pa1, pa2, pa3); SBAR();
    if (SDEPTH == 1 || j + 3 < NT) SLOAD(SE, (j + 1 + SDEPTH) * KVBLK); SBAR();
    pv_d0(o, vb0 + SHM_V, pa0, pa1, pa2, pa3); partialSM(pA0, pA1, m_reg, mnA, alA);
    __syncthreads(); SWAIT(); SWRITE(1, SO);
    RESC(alA); __syncthreads();
  }
  SBAR(); qkt(pB0, pB1, K_lds + SHM_K, qr, qrope, kb);
  finishSM(pA0, pA1, alA, l_reg, pa0, pa1, pa2, pa3); SBAR();
  pv_d0(o, vb0, pa0, pa1, pa2, pa3); partialSM(pB0, pB1, m_reg, mnB, alB);
  __syncthreads(); RESC(alB);
  finishSM(pB0, pB1, alB, l_reg, pa0, pa1, pa2, pa3); SBAR();
  pv_d0(o, vb0 + SHM_V, pa0, pa1, pa2, pa3);
  if (hi == 0) li_l[r32] = l_reg; asm volatile("s_waitcnt lgkmcnt(0)" ::: "memory");
  __syncthreads();
  {
    constexpr int RS = 272;
    int tid_e = threadIdx.x; asm volatile("" : "+v"(tid_e));
    const int wid = tid_e >> 6, lane = tid_e & 63, r32 = lane & 31, hi = lane >> 5;
    char* Ost = lds + wid * (32 * RS);
#pragma unroll
    for (int r = 0; r < 16; ++r) { const int rw = crow(r, hi); const float rl = __builtin_amdgcn_rcpf(li_l[rw]);
#pragma unroll
      for (int d0 = 0; d0 < 4; ++d0) *(bf16_t*)(Ost + rw * RS + (d0 * 32 + r32) * 2) = f2bf(o[d0][r] * rl); }
    asm volatile("s_waitcnt lgkmcnt(0)" ::: "memory");
#pragma unroll
    for (int i = 0; i < 8; ++i) { const int q = lane + 64 * i, row = q >> 4, cc = q & 15; const long orow = wid * QBLK + row;
      const u32x4 ov = *(const u32x4*)(Ost + row * RS + cc * 16); const u32x4 gv = *(const u32x4*)(gate + orow * NZ + cc * 8);
      u32x4 w; w.x = cvt_pk_bf16(bf_lo(ov.x) * bf_lo(gv.x), bf_hi(ov.x) * bf_hi(gv.x)); w.y = cvt_pk_bf16(bf_lo(ov.y) * bf_lo(gv.y), bf_hi(ov.y) * bf_hi(gv.y));
      w.z = cvt_pk_bf16(bf_lo(ov.z) * bf_lo(gv.z), bf_hi(ov.z) * bf_hi(gv.z)); w.w = cvt_pk_bf16(bf_lo(ov.w) * bf_lo(gv.w), bf_hi(ov.w) * bf_hi(gv.w));
      *(u32x4*)(Yo + orow * 4096 + cc * 8) = w; }
  }
  __syncthreads();
#undef SLOAD
#undef SWRITE
#undef SWAIT
#undef RESC
}

constexpr int DMA_KRING = 0, DMA_VRING = 3 * SHM_K, DMA_WS = 3 * SHM_K + 3 * SHM_V, SHM_ATTN_DMA = DMA_WS + NW * 64 * 4;
__device__ __forceinline__ void qkt12(f32x16& p0, f32x16& p1, const char* Ks, const bf16x8 (&qr)[12], const int (&kb)[4]) {
  p0 = f32x16{}; p1 = f32x16{};
#define KLD(d, half) (*reinterpret_cast<const bf16x8*>(Ks + kb[(d) & 3] + ((d) >> 2) * 128 + (half) * (32 * 384)))
  bf16x8 c0 = KLD(0, 0), c1 = KLD(0, 1);
#pragma unroll
  for (int d0 = 0; d0 < 12; ++d0) {
    bf16x8 n0 = c0, n1 = c1;
    if (d0 < 11) { n0 = KLD(d0 + 1, 0); n1 = KLD(d0 + 1, 1); }
    __builtin_amdgcn_sched_group_barrier(0x100, 2, 0);
    p0 = __builtin_amdgcn_mfma_f32_32x32x16_bf16(c0, qr[d0], p0, 0, 0, 0);
    p1 = __builtin_amdgcn_mfma_f32_32x32x16_bf16(c1, qr[d0], p1, 0, 0, 0);
    __builtin_amdgcn_sched_group_barrier(0x008, 2, 0);
    c0 = n0; c1 = n1; }
#undef KLD
}
__device__ __forceinline__ void attn_unit_dma(const bf16_t* __restrict__ Qb, const bf16_t* __restrict__ Kh, const bf16_t* __restrict__ Vh, int seq, char* lds, LAS unsigned char* ldsl,
                                              const bf16_t* __restrict__ gate, bf16_t* __restrict__ Yo, const float* __restrict__ gq, const float* __restrict__ rope, int tok0) {
  const int tid = tid_fresh(), wid = __builtin_amdgcn_readfirstlane(tid >> 6), lane = tid & 63, r32 = lane & 31, hi = lane >> 5;
  float* li_l = (float*)(lds + DMA_WS) + wid * 64;
  float l_reg = 0; f32x16 o[4] = {}; bf16x8 qr[12];
  const bf16_t* Qw = Qb + (long)(wid * QBLK + r32) * LDQ + hi * 8;
#pragma unroll
  for (int d0 = 0; d0 < 12; ++d0) qr[d0] = *reinterpret_cast<const bf16x8*>(Qw + d0 * 16);
  {
    float ss = 0.f;
#pragma unroll
    for (int d0 = 0; d0 < 12; ++d0) { const u32x4 w = *reinterpret_cast<const u32x4*>(&qr[d0]); float f[8]; f[0] = bf_lo(w.x); f[1] = bf_hi(w.x); f[2] = bf_lo(w.y); f[3] = bf_hi(w.y); f[4] = bf_lo(w.z); f[5] = bf_hi(w.z); f[6] = bf_lo(w.w); f[7] = bf_hi(w.w);
#pragma unroll
      for (int e = 0; e < 8; ++e) ss += f[e] * f[e]; }
    ss += __shfl_xor(ss, 32);
    const float rstd = rsqrtf(ss * (1.0f / DQK) + EPS) * (SCALE * 1.4426950408889634f);
#pragma unroll
    for (int d0 = 0; d0 < 8; ++d0) { const u32x4 w = *reinterpret_cast<const u32x4*>(&qr[d0]); float f[8]; f[0] = bf_lo(w.x); f[1] = bf_hi(w.x); f[2] = bf_lo(w.y); f[3] = bf_hi(w.y); f[4] = bf_lo(w.z); f[5] = bf_hi(w.z); f[6] = bf_lo(w.w); f[7] = bf_hi(w.w);
      const f32x4 g0 = *(const f32x4*)(gq + d0 * 16 + hi * 8), g1 = *(const f32x4*)(gq + d0 * 16 + hi * 8 + 4);
      u32x4 o; o.x = cvt_pk_bf16(f[0] * rstd * g0[0], f[1] * rstd * g0[1]); o.y = cvt_pk_bf16(f[2] * rstd * g0[2], f[3] * rstd * g0[3]); o.z = cvt_pk_bf16(f[4] * rstd * g1[0], f[5] * rstd * g1[1]); o.w = cvt_pk_bf16(f[6] * rstd * g1[2], f[7] * rstd * g1[3]);
      qr[d0] = *reinterpret_cast<const bf16x8*>(&o); }
    const int t = tok0 + wid * QBLK + r32;
#pragma unroll
    for (int ax = 0; ax < 2; ++ax) {
      const int pos = tok0 < 0 ? 0 : (ax == 0 ? (t >> 6) : (t & 63));
      const u32x4 w1 = *reinterpret_cast<const u32x4*>(&qr[8 + 2 * ax]), w2 = *reinterpret_cast<const u32x4*>(&qr[9 + 2 * ax]);
      float x1[8], x2[8]; x1[0] = bf_lo(w1.x); x1[1] = bf_hi(w1.x); x1[2] = bf_lo(w1.y); x1[3] = bf_hi(w1.y); x1[4] = bf_lo(w1.z); x1[5] = bf_hi(w1.z); x1[6] = bf_lo(w1.w); x1[7] = bf_hi(w1.w);
      x2[0] = bf_lo(w2.x); x2[1] = bf_hi(w2.x); x2[2] = bf_lo(w2.y); x2[3] = bf_hi(w2.y); x2[4] = bf_lo(w2.z); x2[5] = bf_hi(w2.z); x2[6] = bf_lo(w2.w); x2[7] = bf_hi(w2.w);
      float o1[8], o2[8];
#pragma unroll
      for (int e = 0; e < 8; ++e) { const f32x2 cs = tok0 < 0 ? (f32x2){1.f, 0.f} : *(const f32x2*)(rope + ((size_t)pos * 16 + hi * 8 + e) * 2);
        const float y1 = x1[e] * rstd * gq[128 + 32 * ax + hi * 8 + e], y2 = x2[e] * rstd * gq[144 + 32 * ax + hi * 8 + e];
        o1[e] = y1 * cs.x - y2 * cs.y; o2[e] = y1 * cs.y + y2 * cs.x; }
      u32x4 a, b; a.x = cvt_pk_bf16(o1[0], o1[1]); a.y = cvt_pk_bf16(o1[2], o1[3]); a.z = cvt_pk_bf16(o1[4], o1[5]); a.w = cvt_pk_bf16(o1[6], o1[7]);
      b.x = cvt_pk_bf16(o2[0], o2[1]); b.y = cvt_pk_bf16(o2[2], o2[3]); b.z = cvt_pk_bf16(o2[4], o2[5]); b.w = cvt_pk_bf16(o2[6], o2[7]);
      qr[8 + 2 * ax] = *reinterpret_cast<const bf16x8*>(&a); qr[9 + 2 * ax] = *reinterpret_cast<const bf16x8*>(&b); }
  }
  int kb[4];
#pragma unroll
  for (int d = 0; d < 4; ++d) kb[d] = r32 * 384 + (((d * 2 + hi) ^ ((r32 >> 1) & 7)) << 4);
  unsigned kdo[3], vdo[2];
#pragma unroll
  for (int i = 0; i < 3; ++i) { const int byte = ((wid * 3 + i) * 64 + lane) * 16, row = byte / 384, off = byte - row * 384; kdo[i] = (unsigned)(row * (LDK * 2) + (off ^ (((row >> 1) & 7) << 4))); }
#pragma unroll
  for (int i = 0; i < 2; ++i) { const int P = (wid * 2 + i) * 64 + lane, sub = P >> 5, within = P & 31, kk = (sub >> 2) * 8 + (within >> 2), k = (kk & ~0xC) | ((kk & 4) << 1) | ((kk & 8) >> 1), c8 = (sub & 3) * 32 + (within & 3) * 8;
    vdo[i] = (unsigned)(k * (LDV * 2) + c8 * 2); }
  const int vb0 = (int)(uintptr_t)(lds + DMA_VRING) + v_rd_base(lane);
#define KDMA(t, slot) do { const char* g_ = (const char*)Kh + (size_t)(t) * (KVBLK * LDK * 2); _Pragma("unroll") for (int i_ = 0; i_ < 3; ++i_) \
    __builtin_amdgcn_global_load_lds((const unsigned*)(g_ + kdo[i_]), (LAS unsigned*)(ldsl + DMA_KRING + (slot) * SHM_K + (wid * 3 + i_) * 1024), 16, 0, 0); } while (0)
#define VDMA(t, slot) do { const char* g_ = (const char*)Vh + (size_t)(t) * (KVBLK * LDV * 2); _Pragma("unroll") for (int i_ = 0; i_ < 2; ++i_) \
    __builtin_amdgcn_global_load_lds((const unsigned*)(g_ + vdo[i_]), (LAS unsigned*)(ldsl + DMA_VRING + (slot) * SHM_V + (wid * 2 + i_) * 1024), 16, 0, 0); } while (0)
#define NEXT3(s) ((s) == 2 ? 0 : (s) + 1)
#define RESC(a) do { if (__any((a) < 1.f)) { _Pragma("unroll") for (int r = 0; r < 16; ++r) { const float ar_ = __shfl((a), crow(r, hi)); \
    _Pragma("unroll") for (int d = 0; d < 4; ++d) o[d][r] *= ar_; } } } while (0)
#define TOP(t, st) do { if ((t) + 2 < NT) asm volatile("s_waitcnt vmcnt(5)" ::: "memory"); else asm volatile("s_waitcnt vmcnt(0)" ::: "memory"); \
    __builtin_amdgcn_s_barrier(); asm volatile("" ::: "memory"); \
    if ((t) + 2 < NT) KDMA((t) + 2, NEXT3(NEXT3(st))); if ((t) + 1 < NT) VDMA((t) + 1, NEXT3(st)); } while (0)
  f32x16 pA0, pA1, pB0, pB1; bf16x8 pa0, pa1, pa2, pa3; const int NT = seq / KVBLK;
  KDMA(0, 0); VDMA(0, 0); KDMA(1, 1);
  int st = 0;
  TOP(0, st);
  qkt12(pA0, pA1, lds + DMA_KRING + st * SHM_K, qr, kb); partialSM_fix(pA0, pA1);
  for (int j = 1; j + 1 < NT; j += 2) {
    int sp = st; st = NEXT3(st);
    TOP(j, st);
    SBAR(); qkt12(pB0, pB1, lds + DMA_KRING + st * SHM_K, qr, kb);
    finishSM_fix(pA0, pA1, l_reg, pa0, pa1, pa2, pa3); SBAR();
    pv_d0(o, vb0 + sp * SHM_V, pa0, pa1, pa2, pa3); partialSM_fix(pB0, pB1);
    sp = st; st = NEXT3(st);
    TOP(j + 1, st);
    SBAR(); qkt12(pA0, pA1, lds + DMA_KRING + st * SHM_K, qr, kb);
    finishSM_fix(pB0, pB1, l_reg, pa0, pa1, pa2, pa3); SBAR();
    pv_d0(o, vb0 + sp * SHM_V, pa0, pa1, pa2, pa3); partialSM_fix(pA0, pA1);
  }
  { int sp = st; st = NEXT3(st);
    TOP(NT - 1, st);
    SBAR(); qkt12(pB0, pB1, lds + DMA_KRING + st * SHM_K, qr, kb);
    finishSM_fix(pA0, pA1, l_reg, pa0, pa1, pa2, pa3); SBAR();
    pv_d0(o, vb0 + sp * SHM_V, pa0, pa1, pa2, pa3); partialSM_fix(pB0, pB1);
    finishSM_fix(pB0, pB1, l_reg, pa0, pa1, pa2, pa3); SBAR();
    pv_d0(o, vb0 + st * SHM_V, pa0, pa1, pa2, pa3); }
  l_reg += __shfl_xor(l_reg, 32);
  if (hi == 0) li_l[r32] = l_reg; asm volatile("s_waitcnt vmcnt(0) lgkmcnt(0)" ::: "memory");
  __syncthreads();
  {
    constexpr int RS = 272;
    int tid_e = threadIdx.x; asm volatile("" : "+v"(tid_e));
    const int wid = tid_e >> 6, lane = tid_e & 63, r32 = lane & 31, hi = lane >> 5;
    char* Ost = lds + wid * (32 * RS);
#pragma unroll
    for (int r = 0; r < 16; ++r) { const int rw = crow(r, hi); const float rl = __builtin_amdgcn_rcpf(li_l[rw]);
#pragma unroll
      for (int d0 = 0; d0 < 4; ++d0) *(bf16_t*)(Ost + rw * RS + (d0 * 32 + r32) * 2) = f2bf(o[d0][r] * rl); }
    asm volatile("s_waitcnt lgkmcnt(0)" ::: "memory");
#pragma unroll
    for (int i = 0; i < 8; ++i) { const int q = lane + 64 * i, row = q >> 4, cc = q & 15; const long orow = wid * QBLK + row;
      const u32x4 ov = *(const u32x4*)(Ost + row * RS + cc * 16); const u32x4 gv = *(const u32x4*)(gate + orow * NZ + cc * 8);
      u32x4 w; w.x = cvt_pk_bf16(bf_lo(ov.x) * bf_lo(gv.x), bf_hi(ov.x) * bf_hi(gv.x)); w.y = cvt_pk_bf16(bf_lo(ov.y) * bf_lo(gv.y), bf_hi(ov.y) * bf_hi(gv.y));
      w.z = cvt_pk_bf16(bf_lo(ov.z) * bf_lo(gv.z), bf_hi(ov.z) * bf_hi(gv.z)); w.w = cvt_pk_bf16(bf_lo(ov.w) * bf_lo(gv.w), bf_hi(ov.w) * bf_hi(gv.w));
      *(u32x4*)(Yo + orow * 4096 + cc * 8) = w; }
  }
  __syncthreads();
#undef KDMA
#undef VDMA
#undef NEXT3
#undef RESC
#undef TOP
}
#undef KSWZ
}

#define XB_TMO      128
#define XB_XCNT(j)  (256  + 64 * (j))
#define XB_XSUB(j)  (1280 + 64 * (j))
#define XB_XGEN(j)  (2304 + 64 * (j))
#define XB_TOP      3328
#define XB_TOPGEN   3392
#define XCD_BAR_WORDS 3456
#define XB_SPIN_CAP (1u << 18)
__device__ __forceinline__ unsigned xb_ld(unsigned* p)              { return __hip_atomic_load(p, __ATOMIC_RELAXED, __HIP_MEMORY_SCOPE_AGENT); }
__device__ __forceinline__ unsigned xb_add(unsigned* p, unsigned v) { return __hip_atomic_fetch_add(p, v, __ATOMIC_RELAXED, __HIP_MEMORY_SCOPE_AGENT); }
__device__ __forceinline__ unsigned xb_xcc_id() { return (unsigned)__builtin_amdgcn_s_getreg((3 << 11) | 20) & 0xFu; }
#define XB_SPIN(cond, bar) do { unsigned _sp = 0; while (cond) { __builtin_amdgcn_s_sleep(1); \
    if ((++_sp & 255u) == 0u) { if (xb_ld(&(bar)[XB_TMO])) break; if (_sp > XB_SPIN_CAP) { atomicAdd(&(bar)[XB_TMO], 1u); break; } } } } while (0)
struct XcdBarrier { unsigned* bar; unsigned x; volatile LAS unsigned* st; };
__device__ __forceinline__ XcdBarrier xcd_barrier_post(unsigned* bar, volatile LAS unsigned* st) {
    XcdBarrier b; b.bar = bar; b.x = xb_xcc_id(); b.st = st;
    if (threadIdx.x == 0) (void)xb_add(&bar[XB_XCNT(b.x)], 1u);
    return b;
}
__device__ __forceinline__ void xcd_barrier_complete(unsigned* bar, unsigned x, unsigned& nloc, unsigned& nx) {
    const unsigned G = gridDim.x * gridDim.y * gridDim.z;
    unsigned sum, cnt, mine, sp = 0u;
    for (;;) {
        sum = 0u; cnt = 0u; mine = 0u;
#pragma unroll
        for (unsigned j = 0; j < 16; ++j) { const unsigned c = xb_ld(&bar[XB_XCNT(j)]); sum += c; cnt += (c > 0u) ? 1u : 0u; mine = (j == x) ? c : mine; }
        if (sum == G) break;
        __builtin_amdgcn_s_sleep(1);
        if ((++sp & 255u) == 0u) { if (xb_ld(&bar[XB_TMO])) break; if (sp > XB_SPIN_CAP) { atomicAdd(&bar[XB_TMO], 1u); break; } }
    }
    nloc = mine > 0u ? mine : 1u; nx = cnt > 0u ? cnt : 1u;
}
__device__ __forceinline__ void xcd_barrier(const XcdBarrier& b) {
    asm volatile("s_waitcnt vmcnt(0)" ::: "memory");
    __syncthreads();
    if (threadIdx.x == 0) {
        unsigned* bar = b.bar; asm volatile("" : "+s"(bar));
        __builtin_amdgcn_s_waitcnt(0);
        unsigned bx_ = b.x; asm volatile("" : "+s"(bx_));
        unsigned nloc = b.st[0], nx = b.st[1];
        if (nloc == 0u) { xcd_barrier_complete(bar, bx_, nloc, nx); b.st[0] = nloc; b.st[1] = nx; }
        const unsigned old = xb_add(&bar[XB_XSUB(bx_)], 1u);
        const unsigned gen = old / nloc;
        if (old + 1u == (gen + 1u) * nloc) {
            __builtin_amdgcn_fence(__ATOMIC_RELEASE, "agent");
            asm volatile("s_waitcnt vmcnt(0)" ::: "memory");
            const unsigned og = xb_add(&bar[XB_TOP], 1u);
            const unsigned tg = og / nx;
            if (og + 1u == (tg + 1u) * nx) xb_add(&bar[XB_TOPGEN], 1u);
            else XB_SPIN(xb_ld(&bar[XB_TOPGEN]) == tg, bar);
            __builtin_amdgcn_fence(__ATOMIC_ACQUIRE, "agent");
            xb_add(&bar[XB_XGEN(bx_)], 1u);
            asm volatile("s_waitcnt vmcnt(0)" ::: "memory");
        } else {
            XB_SPIN(xb_ld(&bar[XB_XGEN(bx_)]) == gen, bar);
            __builtin_amdgcn_fence(__ATOMIC_ACQUIRE, "agent");
            asm volatile("s_waitcnt vmcnt(0)" ::: "memory");
        }
    }
    __syncthreads();
}

struct Args {
    const float* in[24]; float* out; unsigned char* ws; int ph_lo, ph_hi;
};

struct Frame {
    LAS unsigned char* lds; char* ldsg;
    int tid, lane, wave, vcu, G, bx;
    const float* const* in; float* out; unsigned char* ws;
};
template <class T> __device__ __forceinline__ T* wsp(const Frame& F, size_t off) { return (T*)(F.ws + off); }

__device__ __forceinline__ void p0_transpose_item(const float* W, int N, bf16_t* WT, int ldt, int k0, int n0, int nrow0, int kcol0, LAS float* scr, int lane) {
#pragma unroll 8
    for (int i = 0; i < 32; ++i) { const int kk = 2 * i + (lane >> 5); scr[kk * 33 + (lane & 31)] = W[(size_t)(k0 + kk) * N + n0 + (lane & 31)]; }
    LDS_WAIT(); asm volatile("" ::: "memory");
    const int c = lane & 7;
#pragma unroll
    for (int j = 0; j < 4; ++j) { const int n = (lane >> 3) + 8 * j; const LAS float* s = scr + (8 * c) * 33 + n;
        u32x4 o; o.x = cvt_pk_bf16(s[0 * 33], s[1 * 33]); o.y = cvt_pk_bf16(s[2 * 33], s[3 * 33]); o.z = cvt_pk_bf16(s[4 * 33], s[5 * 33]); o.w = cvt_pk_bf16(s[6 * 33], s[7 * 33]);
        *(u32x4*)(WT + (size_t)(nrow0 + n) * ldt + kcol0 + k0 + 8 * c) = o; }
    LDS_WAIT(); asm volatile("" ::: "memory");
}
struct TrJob { int in_idx; int K, N; size_t lw_off; int ldt; int kcol0; };
__device__ __forceinline__ void p0_prologue(const Frame& F) {
    {
        LAS float* sv = (LAS float*)(F.lds);
        LAS float* red = (LAS float*)(F.lds + 4096);
        const float* cvec = F.in[1]; const float* cctx = F.in[3];
        float* MOD = wsp<float>(F, WS_MOD);
        for (int it = F.bx; it < 2 * 32 * 24; it += F.G) {
            const int l = it / 768, r = it % 768, kc = r / 24, nb = r % 24;
            const float* W = F.in[5] + (size_t)l * DM * 12288; const float* bias = F.in[6] + (size_t)l * 12288;
            if (F.tid < 384) { const int j = F.tid >> 7, k = kc * 128 + (F.tid & 127); const float v = j < 2 ? cvec[j * DM + k] : cctx[k]; sv[F.tid] = v * sigmoidf_(v); }
            __syncthreads();
            const int cg = F.tid & 127, rs = F.tid >> 7, n = nb * 512 + cg * 4;
            f32x4 a0 = {0.f, 0.f, 0.f, 0.f}, a1 = a0, a2 = a0;
#pragma unroll 8
            for (int i = 0; i < 32; ++i) { const int kk = rs + 4 * i; const f32x4 w = *(const f32x4*)(W + (size_t)(kc * 128 + kk) * 12288 + n);
                a0 += w * sv[kk]; a1 += w * sv[128 + kk]; a2 += w * sv[256 + kk]; }
            *(LAS f32x4*)(red + (rs * 3 + 0) * 512 + cg * 4) = a0; *(LAS f32x4*)(red + (rs * 3 + 1) * 512 + cg * 4) = a1; *(LAS f32x4*)(red + (rs * 3 + 2) * 512 + cg * 4) = a2;
            __syncthreads();
            for (int e = F.tid; e < 1536; e += NTHR) { const int j = e >> 9, col = e & 511;
                float s = red[(0 * 3 + j) * 512 + col] + red[(1 * 3 + j) * 512 + col] + red[(2 * 3 + j) * 512 + col] + red[(3 * 3 + j) * 512 + col];
                if (kc == 0) s += bias[nb * 512 + col];
                atomicAdd(MOD + ((size_t)l * 3 + j) * 12288 + nb * 512 + col, s); }
            __syncthreads();
        }
    }
    const int gw = F.vcu * NWAVES + F.wave, NGW = F.G * NWAVES;
#pragma unroll 1
    for (int rep0 = 0; rep0 < DUP_P0; ++rep0)
    {
        LAS float* scr = (LAS float*)(F.lds + F.wave * 16384);
        const TrJob jobs[9] = { {7, 4096, NIN, LW_IN, 4096, 0}, {9, 768, 3072, LW_UQ, 768, 0}, {11, 512, 4096, LW_UKV, 512, 0}, {14, 1024, 1024, LW_FN, 1024, 0}, {19, 1024, 1024, LW_PW2, 1024, 0},
                                {20, 1024, 4096, LW_BR, 4096, 0}, {21, 2048, 4096, LW_BR, 4096, 1024}, {22, 1024, 4096, LW_BR, 4096, 3072}, {23, 4096, 4096, LW_OUT, 4096, 0} };
        int base = 0;
#pragma unroll
        for (int l = 0; l < NL; ++l)
#pragma unroll
            for (int jb = 0; jb < 9; ++jb) {
                const TrJob J = jobs[jb]; const int nblk = J.N / 32, nitems = (J.K / 64) * nblk;
                const float* W = F.in[J.in_idx] + (size_t)l * J.K * J.N; bf16_t* WT = (bf16_t*)(F.ws + WS_W + (size_t)l * LAYER_W + J.lw_off);
                int first = (gw - base % NGW + NGW) % NGW;
                for (int it = first; it < nitems; it += NGW) { const int kb = it / nblk, nbk = it % nblk, n0 = nbk * 32;
                    const int nrow0 = (jb == 0 && n0 >= 3392) ? n0 + 192 : n0;
                    p0_transpose_item(W, J.N, WT, J.ldt, kb * 64, n0, nrow0, J.kcol0, scr, F.lane); }
                base += nitems;
            }
    }
    const size_t gt = (size_t)F.vcu * NTHR + F.tid, NGT = (size_t)F.G * NTHR;
    for (int l = 0; l < NL; ++l) { u32x4* p = (u32x4*)(F.ws + WS_W + (size_t)l * LAYER_W + LW_IN + (size_t)3392 * DM * 2);
        for (size_t i = gt; i < (size_t)192 * DM * 2 / 16; i += NGT) p[i] = (u32x4){0u, 0u, 0u, 0u}; }
    {
        bf16_t* TAB = wsp<bf16_t>(F, WS_COS);
        for (size_t i = gt; i < (size_t)2048 * 256; i += NGT) { const int k = (int)(i >> 8), s0 = ((int)i & 255) * 8; float ce[8], se[8], co[8], so[8];
#pragma unroll
            for (int j = 0; j < 8; ++j) { const int pe = (2 * k * (s0 + j)) & 8191, po = ((2 * k + 1) * (s0 + j)) & 8191;
                sincospif((float)pe * (1.0f / 4096.0f), &se[j], &ce[j]); sincospif((float)po * (1.0f / 4096.0f), &so[j], &co[j]); }
            const size_t o = (size_t)k * 2048 + s0;
            *(u32x4*)(TAB + o) = pack8(ce); *(u32x4*)(TAB + (size_t)1 * 2048 * 2048 + o) = pack8(co);
            *(u32x4*)(TAB + (size_t)2 * 2048 * 2048 + o) = pack8(se); *(u32x4*)(TAB + (size_t)3 * 2048 * 2048 + o) = pack8(so); }
        bf16_t* CS = wsp<bf16_t>(F, WS_CS);
        for (size_t i = gt; i < (size_t)1024 * 128; i += NGT) { const int m = (int)(i >> 7), c0 = ((int)i & 127) * 8; float cv[8], sv[8];
#pragma unroll
            for (int j = 0; j < 8; ++j) { const int p = (m * (c0 + j)) & 1023; sincospif((float)p * (1.0f / 512.0f), &sv[j], &cv[j]); }
            u32x4 a, b; a.x = cvt_pk_bf16(cv[0], cv[1]); a.y = cvt_pk_bf16(cv[2], cv[3]); a.z = cvt_pk_bf16(cv[4], cv[5]); a.w = cvt_pk_bf16(cv[6], cv[7]);
            b.x = cvt_pk_bf16(sv[0], sv[1]); b.y = cvt_pk_bf16(sv[2], sv[3]); b.z = cvt_pk_bf16(sv[4], sv[5]); b.w = cvt_pk_bf16(sv[6], sv[7]);
            *(u32x4*)(CS + (size_t)m * 1024 + c0) = a; *(u32x4*)(CS + (size_t)(1024 + m) * 1024 + c0) = b; }
        bf16_t* CS256 = wsp<bf16_t>(F, WS_CS256);
        for (size_t i = gt; i < (size_t)256 * 32; i += NGT) { const int k = (int)(i >> 5), s0 = ((int)i & 31) * 8; float cv[8], sv[8];
#pragma unroll
            for (int j = 0; j < 8; ++j) { const int p = (k * (s0 + j)) & 255; sincospif((float)p * (1.0f / 128.0f), &sv[j], &cv[j]); }
            u32x4 a, b; a.x = cvt_pk_bf16(cv[0], cv[1]); a.y = cvt_pk_bf16(cv[2], cv[3]); a.z = cvt_pk_bf16(cv[4], cv[5]); a.w = cvt_pk_bf16(cv[6], cv[7]);
            b.x = cvt_pk_bf16(-sv[0], -sv[1]); b.y = cvt_pk_bf16(-sv[2], -sv[3]); b.z = cvt_pk_bf16(-sv[4], -sv[5]); b.w = cvt_pk_bf16(-sv[6], -sv[7]);
            *(u32x4*)(CS256 + (size_t)k * 512 + s0) = a; *(u32x4*)(CS256 + (size_t)k * 512 + 256 + s0) = b; }
        float* ROPE = wsp<float>(F, WS_ROPE);
        for (size_t i = gt; i < 128 * 16; i += NGT) { const int pos = (int)i >> 4, f = (int)i & 15; const float inv = powf(10000.0f, -(float)f / 16.0f); const float ang = (float)pos * inv;
            float s, c; sincosf(ang, &s, &c); ROPE[i * 2] = c; ROPE[i * 2 + 1] = s; }
    }
}

__device__ __forceinline__ void phase_norm_mod(const Frame& F, int layer, const float* xl, const float* xc) {
    const int gw = F.vcu * NWAVES + F.wave, NGW = F.G * NWAVES;
    const float* g = F.in[4] + (size_t)layer * DM; bf16_t* H = wsp<bf16_t>(F, WS_H);
    for (int m = gw; m < MROWS; m += NGW) {
        const int b = m / SB, p = m - b * SB; const bool isctx = p < CTX;
        const float* src = isctx ? xc + ((size_t)b * CTX + p) * DM : xl + ((size_t)b * SEQ + (p - CTX)) * DM;
        const float* mod = wsp<float>(F, WS_MOD) + ((size_t)layer * 3 + (isctx ? 2 : b)) * 12288;
        f32x4 v[16]; float ss = 0.f;
#pragma unroll
        for (int j = 0; j < 16; ++j) v[j] = *(const f32x4*)(src + 4 * (F.lane + 64 * j));
        if (isctx && layer > 0) {
            const float* pj = wsp<float>(F, WS_ECOS) + ((size_t)b * CTX + p) * DM;
#pragma unroll 1
            for (int ch = 0; ch < 8; ++ch)
#pragma unroll
                for (int j = 0; j < 16; ++j) v[j] += *(const f32x4*)(pj + (size_t)ch * 512 * DM + 4 * (F.lane + 64 * j)); }
#pragma unroll
        for (int j = 0; j < 16; ++j) ss += (v[j].x * v[j].x + v[j].y * v[j].y) + (v[j].z * v[j].z + v[j].w * v[j].w);
        const float rstd = rsqrtf(wave_sum(ss) * (1.0f / DM) + EPS);
#pragma unroll
        for (int j = 0; j < 16; ++j) { const int n = 4 * (F.lane + 64 * j);
            const f32x4 gv = *(const f32x4*)(g + n), sh = *(const f32x4*)(mod + n), sc = *(const f32x4*)(mod + DM + n);
            const f32x4 y = v[j] * rstd * gv; const f32x4 h = y * (sc + 1.0f) + sh;
            u32x2 w; w.x = cvt_pk_bf16(h.x, h.y); w.y = cvt_pk_bf16(h.z, h.w); *(u32x2*)(H + (size_t)m * DM + n) = w; }
    }
}


__device__ __forceinline__ void phase_c1_lora_norm(const Frame& F, int layer) {
    const int gw = F.vcu * NWAVES + F.wave, NGW = F.G * NWAVES;
    const bf16_t* Z = wsp<bf16_t>(F, WS_Z); bf16_t* NCQ = wsp<bf16_t>(F, WS_NCQ); bf16_t* NCKV = wsp<bf16_t>(F, WS_NCKV);
    const float* gq = F.in[8] + (size_t)layer * QLORA; const float* gkv = F.in[10] + (size_t)layer * KVLORA;
    for (int m = gw; m < MROWS; m += NGW) {
        const bf16_t* zr = Z + (size_t)m * NZ;
        float a[8], b2[8], c[8]; const bool has2 = F.lane < 32;
        unpack8(*(const u32x4*)(zr + ZC_Q + F.lane * 8), a);
        if (has2) unpack8(*(const u32x4*)(zr + ZC_Q + 512 + F.lane * 8), b2); else {
#pragma unroll
            for (int j = 0; j < 8; ++j) b2[j] = 0.f; }
        unpack8(*(const u32x4*)(zr + ZC_KV + F.lane * 8), c);
        float sq = 0.f, sk = 0.f;
#pragma unroll
        for (int j = 0; j < 8; ++j) { sq += a[j] * a[j] + b2[j] * b2[j]; sk += c[j] * c[j]; }
        const float rq = rsqrtf(wave_sum(sq) * (1.0f / QLORA) + EPS), rk = rsqrtf(wave_sum(sk) * (1.0f / KVLORA) + EPS);
#pragma unroll
        for (int j = 0; j < 8; ++j) { a[j] *= rq * gq[F.lane * 8 + j]; c[j] *= rk * gkv[F.lane * 8 + j]; }
        *(u32x4*)(NCQ + (size_t)m * QLORA + F.lane * 8) = pack8(a);
        *(u32x4*)(NCKV + (size_t)m * KVLORA + F.lane * 8) = pack8(c);
        if (has2) {
#pragma unroll
            for (int j = 0; j < 8; ++j) b2[j] *= rq * gq[512 + F.lane * 8 + j];
            *(u32x4*)(NCQ + (size_t)m * QLORA + 512 + F.lane * 8) = pack8(b2); }
    }
}
__device__ __forceinline__ void phase_c2_fold(const Frame& F, int layer) {
    const bf16_t* Z = wsp<bf16_t>(F, WS_Z); bf16_t* EO = wsp<bf16_t>(F, WS_EO); float* V2 = wsp<float>(F, WS_V2) + (size_t)layer * 2048;
    LAS float* red = (LAS float*)F.lds;
    for (int it = F.bx; it < 256; it += F.G) {
        const int b = it >> 7, ch = it & 127;
        const bf16_t* U = Z + ((size_t)b * SB + CTX) * NZ + ZC_F;
        float v2a[16];
#pragma unroll
        for (int j = 0; j < 16; ++j) v2a[j] = 0.f;
#pragma unroll 1
        for (int i = 0; i < 2; ++i) {
            const int s = ch * 16 + F.wave + 8 * i; const float sg = (s & 1) ? -1.f : 1.f;
#pragma unroll
            for (int hh = 0; hh < 2; ++hh) {
                asm volatile("" ::: "memory");
                const int col = (F.lane + 64 * hh) * 8;
                float x[8], y[8], p[8], q[8], ep[8], em[8], om[8], op[8];
                if (s == 0) { unpack8(*(const u32x4*)(U + col), x); unpack8(*(const u32x4*)(U + (size_t)4096 * NZ + col), y); unpack8(*(const u32x4*)(U + (size_t)2048 * NZ + col), p); unpack8(*(const u32x4*)(U + (size_t)6144 * NZ + col), q);
#pragma unroll
                    for (int j = 0; j < 8; ++j) { ep[j] = x[j]; em[j] = x[j]; om[j] = 0.f; op[j] = 0.f; v2a[hh * 8 + j] += (x[j] + y[j]) + (p[j] + q[j]); } }
                else { unpack8(*(const u32x4*)(U + (size_t)s * NZ + col), x); unpack8(*(const u32x4*)(U + (size_t)(SEQ - s) * NZ + col), y);
                    unpack8(*(const u32x4*)(U + (size_t)(4096 - s) * NZ + col), p); unpack8(*(const u32x4*)(U + (size_t)(4096 + s) * NZ + col), q);
#pragma unroll
                    for (int j = 0; j < 8; ++j) { const float es = x[j] + y[j], emr = p[j] + q[j], os = x[j] - y[j], omr = p[j] - q[j];
                        ep[j] = es + emr; em[j] = es - emr; om[j] = os - omr; op[j] = os + omr; v2a[hh * 8 + j] += sg * ep[j]; } }
                bf16_t* dst = EO + ((size_t)(b * 4) * 2048 + s) * 1024 + col;
                *(u32x4*)(dst) = pack8(ep); *(u32x4*)(dst + (size_t)2048 * 1024) = pack8(em); *(u32x4*)(dst + (size_t)2 * 2048 * 1024) = pack8(om); *(u32x4*)(dst + (size_t)3 * 2048 * 1024) = pack8(op);
            }
        }
#pragma unroll
        for (int hh = 0; hh < 2; ++hh)
#pragma unroll
            for (int j = 0; j < 8; ++j) red[F.wave * 1024 + (F.lane + 64 * hh) * 8 + j] = v2a[hh * 8 + j];
        __syncthreads();
        for (int c = F.tid; c < 1024; c += NTHR) { float sm = 0.f;
#pragma unroll
            for (int w = 0; w < 8; ++w) sm += red[w * 1024 + c];
            atomicAdd(V2 + b * 1024 + c, sm); }
        __syncthreads();
    }
}
__device__ __forceinline__ void phase_c3_conv(const Frame& F, int layer, bool with_ctx) {
    const bf16_t* Z = wsp<bf16_t>(F, WS_Z); bf16_t* CU = wsp<bf16_t>(F, WS_CU);
    const float* cw = F.in[15] + (size_t)layer * CONVW * CD; const float* cb = F.in[16] + (size_t)layer * CD;
    const float* lg = F.in[17] + (size_t)layer * CD; const float* lb = F.in[18] + (size_t)layer * CD;
    LAS float* red = (LAS float*)F.lds;
    const int c0 = F.tid * 2;
    float w0[CONVW], w1[CONVW];
#pragma unroll
    for (int j = 0; j < CONVW; ++j) { const f32x2 w = *(const f32x2*)(cw + (size_t)j * CD + c0); w0[j] = w.x; w1[j] = w.y; }
    const f32x2 bias = *(const f32x2*)(cb + c0), gam = *(const f32x2*)(lg + c0), bet = *(const f32x2*)(lb + c0);
    for (int un = F.bx; un < MROWS / 32; un += F.G) {
        const int m0 = un * 32, b = m0 / SB, p0 = m0 - b * SB; const bool isctx = p0 < CTX;
        if (isctx && !with_ctx) continue;
        const int seq_lo = b * SB + (isctx ? 0 : CTX), seq_hi = b * SB + (isctx ? CTX : SB);
        float a0[32], a1[32];
#pragma unroll
        for (int t = 0; t < 32; ++t) { a0[t] = bias.x; a1[t] = bias.y; }
#pragma unroll
        for (int i = 0; i < 62; ++i) {
            const int row = m0 - 15 + i; float u0 = 0.f, u1 = 0.f;
            if (row >= seq_lo && row < seq_hi) { const unsigned wa = *(const unsigned*)(Z + (size_t)row * NZ + ZC_GA + c0), wg = *(const unsigned*)(Z + (size_t)row * NZ + ZC_GG + c0);
                u0 = bf_lo(wa) * bf_lo(wg); u1 = bf_hi(wa) * bf_hi(wg); }
#pragma unroll
            for (int t = 0; t < 32; ++t) { const int j = i - t; if (j >= 0 && j < CONVW) { a0[t] = fmaf(w0[j], u0, a0[t]); a1[t] = fmaf(w1[j], u1, a1[t]); } }
        }
#pragma unroll
        for (int t = 0; t < 32; ++t) { const float s = wave_sum(a0[t] + a1[t]); if (F.lane == 0) red[t * 8 + F.wave] = s; }
        __syncthreads();
        if (F.tid < 32) { float s = 0.f;
#pragma unroll
            for (int w = 0; w < 8; ++w) s += red[F.tid * 8 + w];
            red[1024 + F.tid] = s * (1.0f / CD); }
        __syncthreads();
#pragma unroll
        for (int t = 0; t < 32; ++t) { const float mu = red[1024 + t]; a0[t] -= mu; a1[t] -= mu; }
        __syncthreads();
#pragma unroll
        for (int t = 0; t < 32; ++t) { const float s = wave_sum(a0[t] * a0[t] + a1[t] * a1[t]); if (F.lane == 0) red[t * 8 + F.wave] = s; }
        __syncthreads();
        if (F.tid < 32) { float s = 0.f;
#pragma unroll
            for (int w = 0; w < 8; ++w) s += red[F.tid * 8 + w];
            red[1024 + F.tid] = rsqrtf(s * (1.0f / CD) + EPS); }
        __syncthreads();
#pragma unroll
        for (int t = 0; t < 32; ++t) { const float rs = red[1024 + t];
            float y0 = a0[t] * rs * gam.x + bet.x, y1 = a1[t] * rs * gam.y + bet.y;
            y0 *= sigmoidf_(y0); y1 *= sigmoidf_(y1);
            *(unsigned*)(CU + (size_t)(m0 + t) * CD + c0) = cvt_pk_bf16(y0, y1); }
        __syncthreads();
    }
}
__device__ __forceinline__ void phase_d_specials(const Frame& F, int layer) {
    const bf16_t* Z = wsp<bf16_t>(F, WS_Z); const float* V2 = wsp<float>(F, WS_V2) + (size_t)layer * 2048; float* SPEC = wsp<float>(F, WS_SPEC);
    const bf16_t* CSW = wsp<bf16_t>(F, WS_ZF) + (size_t)layer * 2048 * 1024;
    for (int blk = F.bx; blk < 512; blk += F.G) {
        const int o = blk * 16 + (F.tid >> 5), tl = F.tid & 31;
        const int b = o >> 12, which = (o >> 10) & 3, n = o & 1023;
        const bf16_t* U = Z + ((size_t)b * SB + CTX) * NZ + ZC_F; const bf16_t* T = CSW + (size_t)((which == 3 ? 1024 : 0) + n) * 1024 + tl * 32;
        float sm = 0.f;
#pragma unroll
        for (int q = 0; q < 4; ++q) { float t[8], v[8]; unpack8(*(const u32x4*)(T + q * 8), t); const int c = tl * 32 + q * 8;
            if (which == 0) unpack8(*(const u32x4*)(U + (size_t)4096 * NZ + c), v);
            else if (which == 1) {
#pragma unroll
                for (int j = 0; j < 8; ++j) v[j] = V2[b * 1024 + c + j]; }
            else { float p[8], r[8]; unpack8(*(const u32x4*)(U + (size_t)2048 * NZ + c), p); unpack8(*(const u32x4*)(U + (size_t)6144 * NZ + c), r);
#pragma unroll
                for (int j = 0; j < 8; ++j) v[j] = which == 2 ? p[j] + r[j] : p[j] - r[j]; }
#pragma unroll
            for (int j = 0; j < 8; ++j) sm = fmaf(t[j], v[j], sm); }
#pragma unroll
        for (int off = 1; off < 32; off <<= 1) sm += __shfl_xor(sm, off);
        if (tl == 0) SPEC[o] = sm;
    }
}
__device__ __forceinline__ void phase_e_finalize(const Frame& F, int layer, bool q_ctx, bool q_too) {
    const int gw = F.vcu * NWAVES + F.wave, NGW = F.G * NWAVES;
    bf16_t* QR = wsp<bf16_t>(F, WS_QR); const bf16_t* KVR = wsp<bf16_t>(F, WS_KVR); bf16_t* KN = wsp<bf16_t>(F, WS_KN); const bf16_t* Z = wsp<bf16_t>(F, WS_Z);
    const float* ROPE = wsp<float>(F, WS_ROPE);
    const float* gq = F.in[12] + (size_t)layer * DQK; const float* gk = F.in[13] + (size_t)layer * DQK;
    const int h = F.lane >> 2, j4 = F.lane & 3;
    const int c1 = (j4 & 1) + 4 * (j4 >> 1), c2 = c1 + 2;
    for (int m = gw; m < MROWS; m += NGW) {
        const int b = m / SB, p = m - b * SB; const bool isctx = p < CTX; const int t = p - CTX;
        const int pos = (j4 < 2) ? (t >> 6) : (t & 63);
        float cs[8], sn[8];
        if (!isctx) {
#pragma unroll
            for (int i = 0; i < 8; ++i) { const f32x2 r = *(const f32x2*)(ROPE + ((size_t)pos * 16 + (j4 & 1) * 8 + i) * 2); cs[i] = r.x; sn[i] = r.y; } }
        else {
#pragma unroll
            for (int i = 0; i < 8; ++i) { cs[i] = 1.f; sn[i] = 0.f; } }
#pragma unroll
        for (int qk = 0; qk < 2; ++qk) {
            if (qk == 0 && (!q_too || (isctx && !q_ctx))) continue;
            const float* gn = qk == 0 ? gq : gk;
            float x[4][8], r1[8], r2[8];
            if (qk == 0) { const bf16_t* src = QR + (size_t)m * 3072 + h * DQK;
#pragma unroll
                for (int cc = 0; cc < 4; ++cc) unpack8(*(const u32x4*)(src + (4 * j4 + cc) * 8), x[cc]);
                unpack8(*(const u32x4*)(src + DNOPE + c1 * 8), r1); unpack8(*(const u32x4*)(src + DNOPE + c2 * 8), r2); }
            else { const bf16_t* src = KVR + (size_t)m * 4096 + h * 256; const bf16_t* rs = Z + (size_t)m * NZ + ZC_KR;
#pragma unroll
                for (int cc = 0; cc < 4; ++cc) unpack8(*(const u32x4*)(src + (4 * j4 + cc) * 8), x[cc]);
                unpack8(*(const u32x4*)(rs + c1 * 8), r1); unpack8(*(const u32x4*)(rs + c2 * 8), r2); }
            float ss = 0.f;
#pragma unroll
            for (int cc = 0; cc < 4; ++cc)
#pragma unroll
                for (int i = 0; i < 8; ++i) ss += x[cc][i] * x[cc][i];
#pragma unroll
            for (int i = 0; i < 8; ++i) ss += r1[i] * r1[i] + r2[i] * r2[i];
            ss += __shfl_xor(ss, 1); ss += __shfl_xor(ss, 2);
            const float rstd = rsqrtf(ss * (1.0f / DQK) + EPS);
            bf16_t* dst = (qk == 0 ? QR : KN) + (size_t)m * 3072 + h * DQK;
#pragma unroll
            for (int cc = 0; cc < 4; ++cc) {
#pragma unroll
                for (int i = 0; i < 8; ++i) x[cc][i] *= rstd * gn[(4 * j4 + cc) * 8 + i];
                *(u32x4*)(dst + (4 * j4 + cc) * 8) = pack8(x[cc]); }
            float o1[8], o2[8];
#pragma unroll
            for (int i = 0; i < 8; ++i) { const float y1 = r1[i] * rstd * gn[DNOPE + c1 * 8 + i], y2 = r2[i] * rstd * gn[DNOPE + c2 * 8 + i];
                o1[i] = y1 * cs[i] - y2 * sn[i]; o2[i] = y1 * sn[i] + y2 * cs[i]; }
            *(u32x4*)(dst + DNOPE + c1 * 8) = pack8(o1); *(u32x4*)(dst + DNOPE + c2 * 8) = pack8(o2);
        }
    }
}
__device__ __forceinline__ void phase_g_combine(const Frame& F) {
    const size_t gt = (size_t)F.vcu * NTHR + F.tid, NGT = (size_t)F.G * NTHR;
    const float* G12 = wsp<float>(F, WS_G12); const float* SPEC = wsp<float>(F, WS_SPEC); bf16_t* Y = wsp<bf16_t>(F, WS_Y); const bf16_t* Z = wsp<bf16_t>(F, WS_Z);
    const float sc = 0.00034526698300124393f;
    for (size_t i = gt; i < (size_t)2 * 2048 * 128; i += NGT) {
        const int b = (int)(i >> 18), kp = (int)(i >> 7) & 2047, m0 = ((int)i & 127) * 8; const float sg = (kp & 1) ? -1.f : 1.f;
        const float* g = G12 + ((size_t)(b * 4) * 2048 + kp) * 1024 + m0; const size_t js = (size_t)2048 * 1024;
        const float* sp = SPEC + (size_t)(b * 4) * 1024 + m0;
        float e0[8], e1[8], o0[8], o1[8];
#pragma unroll
        for (int hh = 0; hh < 2; ++hh) { const f32x4 g1e = *(const f32x4*)(g + 4 * hh), g1o = *(const f32x4*)(g + js + 4 * hh), g2e = *(const f32x4*)(g + 2 * js + 4 * hh), g2o = *(const f32x4*)(g + 3 * js + 4 * hh);
            const f32x4 E4 = *(const f32x4*)(sp + 4 * hh), E2 = *(const f32x4*)(sp + 2048 + 4 * hh), O2 = *(const f32x4*)(sp + 3072 + 4 * hh);
#pragma unroll
            for (int j = 0; j < 4; ++j) { const float a1 = g1e[j] + sg * E2[j] + E4[j], a2 = g2e[j]; e0[hh * 4 + j] = (a1 - a2) * sc; e1[hh * 4 + j] = (a1 + a2) * sc;
                const float b1 = g1o[j] - E4[j], b2v = g2o[j] + sg * O2[j]; o0[hh * 4 + j] = (b1 - b2v) * sc; o1[hh * 4 + j] = (b1 + b2v) * sc; } }
        const size_t row0 = (size_t)b * SB + CTX; const int k = 2 * kp;
#define YF_STORE(krow, arr) do { const size_t r_ = row0 + (size_t)(krow); float g_[8], o_[8]; unpack8(*(const u32x4*)(Z + r_ * NZ + ZC_FG + m0), g_); \
            _Pragma("unroll") for (int j = 0; j < 8; ++j) o_[j] = (arr)[j] * g_[j]; *(u32x4*)(Y + r_ * 4096 + m0) = pack8(o_); } while (0)
        YF_STORE(k, e0); YF_STORE(k + 1, o0); YF_STORE(SEQ - k - 1, o1);
        if (kp >= 1) YF_STORE(SEQ - k, e1);
        else { const float* zp = SPEC + (size_t)(b * 4 + 1) * 1024 + m0; float z[8];
#pragma unroll
            for (int j = 0; j < 8; ++j) z[j] = zp[j] * sc;
            YF_STORE(4096, z); }
#undef YF_STORE
    }
}

__device__ __forceinline__ bool att_needs_fallback(const float* gq, const float* gk, int lane) {
    float a = fmaxf(fmaxf(fabsf(gq[lane]), fabsf(gq[64 + lane])), fabsf(gq[128 + lane])), b2 = fmaxf(fmaxf(fabsf(gk[lane]), fabsf(gk[64 + lane])), fabsf(gk[128 + lane]));
#pragma unroll
    for (int o_ = 1; o_ < 64; o_ <<= 1) { a = fmaxf(a, __shfl_xor(a, o_)); b2 = fmaxf(b2, __shfl_xor(b2, o_)); }
    const float bound = (192.0f * a * b2) * (att::SCALE * 1.4426950408889634f);
    return !(bound <= 100.0f);
}
constexpr int NPH = 1 + 10 * NL;
__global__ void __launch_bounds__(NTHR, 2) fwd_kernel(Args args) {
    extern __shared__ __attribute__((aligned(16))) unsigned char lds_raw[];
    Frame F;
    F.lds = (LAS unsigned char*)lds_raw; F.ldsg = (char*)lds_raw;
    F.tid = threadIdx.x; F.lane = F.tid & 63; F.wave = __builtin_amdgcn_readfirstlane(F.tid >> 6);
    F.G = gridDim.x; F.bx = blockIdx.x; F.vcu = (F.G % 8 == 0) ? (F.bx % 8) * (F.G / 8) + F.bx / 8 : F.bx;
    F.in = args.in; F.out = args.out; F.ws = args.ws;
    volatile LAS unsigned* MISC = (volatile LAS unsigned*)(F.lds + MISC_OFF);
    for (int u = F.tid; u < (LDS_BYTES - LDSCTL_OFF) / 4; u += NTHR) ((LAS unsigned*)(F.lds + LDSCTL_OFF))[u] = 0u;
    __syncthreads();
    unsigned* barw = (unsigned*)(F.ws + WS_CTL) + CW_BAR;
    XcdBarrier bar; bar.bar = barw; bar.x = 0; bar.st = nullptr;
#if !MK_PER_PHASE
    bar = xcd_barrier_post(barw, MISC + 8);
#define GRID_BAR() xcd_barrier(bar)
#else
    (void)MISC;
#define GRID_BAR() do { } while (0)
#endif
    const int lo = args.ph_lo, hi = args.ph_hi;
#define IN(k) (lo <= (k) && (k) < hi)
#define REFRESH() do { F.tid = tid_fresh(); F.lane = F.tid & 63; F.wave = __builtin_amdgcn_readfirstlane(F.tid >> 6); { unsigned char* w_ = F.ws; asm volatile("" : "+s"(w_)); F.ws = w_; } \
    { int g_ = F.G, b_ = F.bx, v_ = F.vcu; asm volatile("" : "+s"(g_), "+s"(b_), "+s"(v_)); F.G = g_; F.bx = b_; F.vcu = v_; G = g_; bx = b_; wsb = (const char*)F.ws; } } while (0)
#ifdef ONLY_J
#define INJ(j) ((j) == ONLY_J && IN(P + (j)))
#define IN0 (ONLY_J == -1 && IN(0))
#else
#define INJ(j) IN(P + (j))
#define IN0 IN(0)
#endif
#define SEAM(k) do { if (IN(k) && IN((k) + 1)) GRID_BAR(); } while (0)
    int G = F.G, bx = F.bx;
    const char* wsb = (const char*)F.ws;

    if (IN0) { REFRESH(); p0_prologue(F); } SEAM(0);

#pragma unroll 1
    for (int l = 0; l < NL; ++l) {
        const int P = 1 + 10 * l; const bool full = (l == 0);
        const unsigned char* LW = F.ws + WS_W + (size_t)l * LAYER_W;
        const float* MODL = wsp<float>(F, WS_MOD) + (size_t)l * 3 * 12288;
        if (INJ(0)) { for (int rep = 0; rep < DUP_EW; ++rep) { if (rep) GRID_BAR(); REFRESH(); phase_norm_mod(F, l, l == 0 ? F.in[0] : F.out, F.in[2]); } } SEAM(P + 0);
        if (INJ(1)) {
#pragma unroll 1
          for (int rep = 0; rep < DUP_B; ++rep) {
            if (rep) GRID_BAR();
            REFRESH();
            pg8::EpiZ E{wsp<bf16_t>(F, WS_Z)};
            { const int nrow = full ? 66 : 64, u1 = nrow * 41;
              pg8::TileSched S; S.init(wsb + WS_H, DM, LW + LW_IN, DM, DM, full ? 0 : 1, 41, 0, G, bx); pg8::gemm_phase(F.lds, S, E, DM, DM);
              pg8::TileSched S1; S1.init(wsb + WS_H, DM, LW + LW_IN + (size_t)41 * 256 * DM * 2, DM, DM, full ? 0 : 1, 41, 41 * 256, G, (bx + G - u1 % G) % G); pg8::gemm_phase(F.lds, S1, E, DM, DM); }
            {
              pg8::EpiBf16 Ec{wsp<bf16_t>(F, WS_ZF) + (size_t)l * 2048 * 1024, 1024, 1.0f}; pg8::CswSched Sc{(const char*)(LW + LW_FN), wsb + WS_CS, G, (bx + G - (full ? 40 : 136) % G) % G}; pg8::gemm_phase(F.lds, Sc, Ec, 1024, 1024); }
            if (!full) {
                pg8::TileSched S2; S2.init(wsb + WS_H, DM, LW + LW_IN + (size_t)ZC_KV * DM * 2, DM, DM, 2, 3, ZC_KV, G, (bx + G - (64 * 82) % G) % G); pg8::gemm_phase(F.lds, S2, E, DM, DM); }
          }
        } SEAM(P + 1);
        if (INJ(2)) { for (int rep = 0; rep < DUP_EW; ++rep) { if (rep) GRID_BAR(); REFRESH(); phase_c1_lora_norm(F, l); if (!rep) { REFRESH(); phase_c2_fold(F, l); } REFRESH(); phase_c3_conv(F, l, full); } } SEAM(P + 2);
        if (INJ(3)) {
#pragma unroll 1
          for (int rep = 0; rep < DUP_GS; ++rep) {
            if (rep) GRID_BAR();
            REFRESH(); phase_d_specials(F, l);
            int rot = 0;
            { pg8::EpiBf16 E{wsp<bf16_t>(F, WS_KVR), 4096, 1.0f}; pg8::TileSched S; S.init(wsb + WS_NCKV, KVLORA, LW + LW_UKV, KVLORA, KVLORA, 0, 16, 0, G, bx); pg8::gemm_phase(F.lds, S, E, KVLORA, KVLORA); rot += S.units(); }
            { pg8::EpiBf16 E{wsp<bf16_t>(F, WS_QR), 3072, 1.0f}; pg8::TileSched S; S.init(wsb + WS_NCQ, QLORA, LW + LW_UQ, QLORA, QLORA, full ? 0 : 1, 12, 0, G, (bx + G - rot % G) % G); pg8::gemm_phase(F.lds, S, E, QLORA, QLORA); rot += S.units(); }
            { pg8::EpiGate E{wsp<bf16_t>(F, WS_Y), wsp<bf16_t>(F, WS_Z), 3072, ZC_CG, 1.0f}; pg8::TileSched S; S.init(wsb + WS_CU, CD, LW + LW_PW2, CD, CD, full ? 0 : 1, 4, 0, G, (bx + G - rot % G) % G); pg8::gemm_phase(F.lds, S, E, CD, CD); rot += S.units(); }
            const char* CSWl = wsb + WS_ZF + (size_t)l * 2048 * 1024 * 2;
            { pg8::EpiBf16 E{wsp<bf16_t>(F, WS_ECOS), 16384, 1.0f}; pg8::FchanSched S{CSWl, wsb + WS_EO, G, (bx + G - rot % G) % G}; pg8::gemm_phase(F.lds, S, E, 1024, 1024); rot += 256; }
            if (full) { pg8::EpiBf16 E{wsp<bf16_t>(F, WS_TCT), 512, 1.0f}; pg8::FchanCtxSched S{CSWl, wsb + WS_Z, G, (bx + G - rot % G) % G}; pg8::gemm_phase(F.lds, S, E, 1024, NZ); }
          }
        } SEAM(P + 3);
        if (INJ(4)) { REFRESH(); const bool fb = att_needs_fallback(F.in[12] + (size_t)l * DQK, F.in[13] + (size_t)l * DQK, F.lane); phase_e_finalize(F, l, full, fb); } SEAM(P + 4);
        if (INJ(5)) {
#pragma unroll 1
          for (int rep = 0; rep < DUP_F; ++rep) {
            if (rep) GRID_BAR();
            REFRESH();
            const bf16_t* QR = wsp<bf16_t>(F, WS_QR); const bf16_t* KN = wsp<bf16_t>(F, WS_KN); const bf16_t* KVR = wsp<bf16_t>(F, WS_KVR); const bf16_t* Z = wsp<bf16_t>(F, WS_Z); bf16_t* Y = wsp<bf16_t>(F, WS_Y);
            const int nun = 1024 + (full ? 32 : 0); const bool fb = att_needs_fallback(F.in[12] + (size_t)l * DQK, F.in[13] + (size_t)l * DQK, F.tid & 63);
#define ATT_UNIT_DECODE() \
                const int L = i * G + bx; if (L >= nun) break; \
                int bh, qb = 0, seq; size_t qrow; \
                if (L < 1024) { const int rnd = L / 256, w = L % 256; bh = rnd * 8 + (w & 7); qb = w >> 3; seq = SB; qrow = (size_t)(bh >> 4) * SB + CTX + (size_t)qb * 256; } \
                else { bh = L - 1024; seq = CTX; qrow = (size_t)(bh >> 4) * SB; } \
                const int b = bh >> 4, h = bh & 15; const size_t krow = (size_t)b * SB;
            if (__builtin_expect(!fb, 1)) {
                for (int i = 0;; ++i) { ATT_UNIT_DECODE()
                    att::attn_unit_dma(QR + qrow * 3072 + h * DQK, KN + krow * 3072 + h * DQK, KVR + krow * 4096 + h * 256 + 128, seq, F.ldsg, F.lds,
                               Z + qrow * NZ + ZC_MG + h * 128, Y + qrow * 4096 + 1024 + h * 128, F.in[12] + (size_t)l * DQK, wsp<float>(F, WS_ROPE), L < 1024 ? qb * 256 : -1); }
            } else {
                for (int i = 0;; ++i) { ATT_UNIT_DECODE()
                    att::attn_unit(QR + qrow * 3072 + h * DQK, KN + krow * 3072 + h * DQK, KVR + krow * 4096 + h * 256 + 128, seq, F.ldsg,
                               Z + qrow * NZ + ZC_MG + h * 128, Y + qrow * 4096 + 1024 + h * 128); }
            }
#undef ATT_UNIT_DECODE
            __syncthreads();
#ifndef NO_F2
            { pg8::EpiF32 E{wsp<float>(F, WS_G12), 1024}; pg8::FseqSched S{wsb, G, bx}; pg8::gemm_phase(F.lds, S, E, 2048, 16384); }
            if (full) { pg8::EpiGate E{wsp<bf16_t>(F, WS_Y), wsp<bf16_t>(F, WS_Z), 0, ZC_FG, 0.001953125f}; pg8::FseqCtxSched S{wsb + WS_CS256, wsb + WS_TCT, G, (bx + G - 32) % G}; pg8::gemm_phase(F.lds, S, E, 512, 512); }
#endif
          }
        } SEAM(P + 5);
        if (INJ(6)) { for (int rep = 0; rep < DUP_EW; ++rep) { if (rep) GRID_BAR(); REFRESH(); phase_g_combine(F); } } SEAM(P + 6);
        if (INJ(8)) { for (int rep = 0; rep < DUP_GS; ++rep) { if (rep) GRID_BAR(); REFRESH(); pg8::EpiMerge E{wsp<bf16_t>(F, WS_MRG), wsp<bf16_t>(F, WS_Z)}; pg8::MergeSched S{wsb + WS_Y, (const char*)(LW + LW_BR), 1, 64, G, bx}; pg8::gemm_phase(F.lds, S, E, 4096, 4096); }
            if (full) {
                pg8::EpiMergePart E{wsp<float>(F, WS_G12), wsp<bf16_t>(F, WS_Z)}; pg8::CtxSplitSched S{wsb + WS_Y, (const char*)(LW + LW_BR), 1, G, bx}; pg8::gemm_phase(F.lds, S, E, 4096, 4096); }
        } SEAM(P + 8);
        if (INJ(9)) {
            REFRESH();
            if (full) {
                REFRESH();
                const size_t gt = (size_t)F.vcu * NTHR + F.tid, NGT = (size_t)F.G * NTHR; const float* PI = wsp<float>(F, WS_G12); bf16_t* MR = wsp<bf16_t>(F, WS_MRG);
                for (size_t i = gt; i < (size_t)512 * 512; i += NGT) { const int r = (int)(i >> 9), c8 = ((int)i & 511) * 8; float a[8];
#pragma unroll
                    for (int j = 0; j < 8; ++j) a[j] = 0.f;
#pragma unroll 1
                    for (int ch = 0; ch < 8; ++ch) { const f32x4 x0 = *(const f32x4*)(PI + ((size_t)ch * 512 + r) * 4096 + c8), x1 = *(const f32x4*)(PI + ((size_t)ch * 512 + r) * 4096 + c8 + 4);
                        a[0] += x0[0]; a[1] += x0[1]; a[2] += x0[2]; a[3] += x0[3]; a[4] += x1[0]; a[5] += x1[1]; a[6] += x1[2]; a[7] += x1[3]; }
                    const size_t m = (size_t)(r >> 8) * SB + (r & 255);
                    *(u32x4*)(MR + m * 4096 + c8) = pack8(a); }
                GRID_BAR();
            }
            pg8::EpiOut E{l == 0 ? F.in[0] : F.out, F.in[2], F.out, wsp<float>(F, WS_XC1), MODL};
            pg8::TileSched S; S.init(wsb + WS_MRG, DM, LW + LW_OUT, DM, DM, 1, 16, 0, G, bx); pg8::gemm_phase(F.lds, S, E, DM, DM);
            if (full) { pg8::EpiOutPart E2{wsp<float>(F, WS_ECOS), MODL}; pg8::CtxSplitSched S2{wsb + WS_MRG, (const char*)(LW + LW_OUT), 0, G, bx}; pg8::gemm_phase(F.lds, S2, E2, 4096, 4096); }
        } SEAM(P + 9);
    }
#undef IN
#undef SEAM
#undef GRID_BAR
}

extern "C" void kernel_launch(void* const* d_in, const int* in_sizes, int n_in, void* d_out, int out_size, void* d_ws, size_t ws_size, hipStream_t stream) {
    static int grid = 0;
    if (grid == 0) {
        if (n_in != 24 || out_size != NB * SEQ * DM || ws_size < WS_END) { fprintf(stderr, "kernel_launch: unexpected shapes: n_in %d out %d ws %zu (need %zu)\n", n_in, out_size, ws_size, (size_t)WS_END); grid = -1; return; }
        int dev = 0, cus = 0, per_cu = 0;
        if (hipGetDevice(&dev) != hipSuccess || hipDeviceGetAttribute(&cus, hipDeviceAttributeMultiprocessorCount, dev) != hipSuccess) { grid = -1; return; }
        if (hipFuncSetAttribute((const void*)fwd_kernel, hipFuncAttributeMaxDynamicSharedMemorySize, LDS_BYTES) != hipSuccess) { fprintf(stderr, "kernel_launch: hipFuncSetAttribute failed\n"); grid = -1; return; }
        if (hipOccupancyMaxActiveBlocksPerMultiprocessor(&per_cu, (const void*)fwd_kernel, NTHR, LDS_BYTES) != hipSuccess || per_cu < 1) fprintf(stderr, "kernel_launch: occupancy query says %d\n", per_cu);
        (void)hipGetLastError();
        grid = cus;
    }
    if (grid < 0) return;
    (void)hipMemsetAsync((char*)d_ws + WS_CTL, 0, ZERO_BYTES, stream);
    Args a{};
    for (int i = 0; i < 24; ++i) a.in[i] = (const float*)d_in[i];
    a.out = (float*)d_out; a.ws = (unsigned char*)d_ws;
#if MK_PER_PHASE
    for (int p = 0; p < NPH; ++p) { a.ph_lo = p; a.ph_hi = p + 1; hipLaunchKernelGGL(fwd_kernel, dim3(grid), dim3(NTHR), LDS_BYTES, stream, a); }
#else
    a.ph_lo = 0; a.ph_hi = NPH; hipLaunchKernelGGL(fwd_kernel, dim3(grid), dim3(NTHR), LDS_BYTES, stream, a);
#endif
    const hipError_t le = hipPeekAtLastError();
    if (le != hipSuccess) fprintf(stderr, "kernel_launch: launch failed: %s\n", hipGetErrorName(le));
}
```

```cpp
#include <hip/hip_runtime.h>
#include <cstdio>
#include <cstdint>

#ifndef MK_PER_PHASE
#define MK_PER_PHASE 0
#endif

#define DUP_P0 1
#define DUP_B 1
#define DUP_F 1
#define DUP_EW 1
#define DUP_GS 1
#define ATT_DMA 1

#define LAS __attribute__((address_space(3)))
#define GAS __attribute__((address_space(1)))
typedef unsigned short bf16_t;
typedef short bf16x8 __attribute__((ext_vector_type(8)));
typedef short s16x4 __attribute__((ext_vector_type(4)));
typedef float f32x4 __attribute__((ext_vector_type(4)));
typedef float f32x2 __attribute__((ext_vector_type(2)));
typedef float f32x16 __attribute__((ext_vector_type(16)));
typedef unsigned u32x4 __attribute__((ext_vector_type(4)));
typedef unsigned u32x2 __attribute__((ext_vector_type(2)));

constexpr int DM = 4096, NB = 2, SEQ = 8192, CTX = 256, NL = 2;
constexpr int SB = SEQ + CTX;
constexpr int MROWS = NB * SB;
constexpr int TPB = SB / 256;
constexpr int NIN = 20800, NZ = 20992;
constexpr int ZC_F = 0, ZC_FG = 1024, ZC_Q = 2048, ZC_KV = 2816, ZC_KR = 3328, ZC_MG = 3584, ZC_GA = 5632, ZC_GG = 6656, ZC_CG = 7680,
              ZC_MF = 8704, ZC_MM = 12800, ZC_MC = 16896;
constexpr int NH = 16, DQK = 192, DNOPE = 128, DROPE = 64, DVH = 128, QLORA = 768, KVLORA = 512;
constexpr int FD = 1024, CD = 1024, MLA = 2048, CONVW = 31;
constexpr float EPS = 1e-6f;
constexpr int NWAVES = 8, NTHR = 512;

constexpr size_t al256(size_t x) { return (x + 255) & ~size_t(255); }
constexpr size_t MiB = size_t(1) << 20;
constexpr size_t WS_CTL = 0;
constexpr size_t WS_MOD = 1 * MiB;
constexpr size_t WS_V2 = WS_MOD + al256(size_t(2) * 3 * 12288 * 4);
constexpr size_t ZERO_BYTES = 2 * MiB;
constexpr size_t WS_SPEC = 2 * MiB;
constexpr size_t WS_ROPE = WS_SPEC + 32768;
constexpr size_t WS_CS256 = WS_ROPE + 16384;
constexpr size_t WS_CS = al256(WS_CS256 + 262144);
constexpr size_t WS_COS = WS_CS + 4 * MiB;
constexpr size_t WS_SIN = WS_COS + 32 * MiB;
constexpr size_t WS_W = WS_SIN + 32 * MiB;
constexpr size_t LW_IN = 0, LW_UQ = LW_IN + size_t(NZ) * DM * 2, LW_UKV = LW_UQ + size_t(3072) * 768 * 2, LW_FN = LW_UKV + size_t(4096) * 512 * 2,
                 LW_PW2 = LW_FN + size_t(1024) * 1024 * 2, LW_BR = LW_PW2 + size_t(1024) * 1024 * 2, LW_OUT = LW_BR + size_t(4096) * 4096 * 2,
                 LAYER_W = LW_OUT + size_t(4096) * 4096 * 2;
constexpr size_t WS_H = WS_W + 2 * LAYER_W;
constexpr size_t WS_Z = WS_H + size_t(MROWS) * DM * 2;
constexpr size_t WS_NCQ = WS_Z + size_t(MROWS) * NZ * 2;
constexpr size_t WS_NCKV = WS_NCQ + size_t(MROWS) * 768 * 2;
constexpr size_t WS_EO = WS_NCKV + size_t(MROWS) * 512 * 2;
constexpr size_t WS_CU = WS_EO + size_t(16384) * 1024 * 2;
constexpr size_t WS_QR = WS_CU + size_t(MROWS) * 1024 * 2;
constexpr size_t WS_KVR = WS_QR + size_t(MROWS) * 3072 * 2;
constexpr size_t WS_KN = WS_KVR + size_t(MROWS) * 4096 * 2;
constexpr size_t WS_Y = WS_KN + size_t(MROWS) * 3072 * 2;
constexpr size_t WS_ECOS = WS_Y + size_t(MROWS) * 4096 * 2;
constexpr size_t WS_TCT = WS_ECOS + size_t(2048) * 16384 * 2;
constexpr size_t WS_G12 = WS_TCT + size_t(2048) * 512 * 2;
constexpr size_t WS_ZF = WS_G12 + size_t(16384) * 1024 * 4;
constexpr size_t WS_MRG = WS_ZF + size_t(MROWS) * 1024 * 2;
constexpr size_t WS_XC1 = WS_MRG + size_t(MROWS) * 4096 * 2;
constexpr size_t WS_END = WS_XC1 + size_t(512) * 4096 * 4;

constexpr int CW_TMO = 0, CW_BAR = 4096;

constexpr int RING_BYTES = 131072, LDSCTL_OFF = RING_BYTES, MISC_OFF = LDSCTL_OFF + 320, LDS_BYTES = 147456;

__device__ __forceinline__ float bf_lo(unsigned w) { return __uint_as_float(w << 16); }
__device__ __forceinline__ float bf_hi(unsigned w) { return __uint_as_float(w & 0xffff0000u); }
__device__ __forceinline__ float bf2f(bf16_t b) { return __uint_as_float(((unsigned)b) << 16); }
__device__ __forceinline__ unsigned cvt_pk_bf16(float lo, float hi) { unsigned r; asm volatile("v_cvt_pk_bf16_f32 %0, %1, %2" : "=v"(r) : "v"(lo), "v"(hi)); return r; }
__device__ __forceinline__ bf16_t f2bf(float f) { return (bf16_t)(cvt_pk_bf16(f, 0.f) & 0xffffu); }
__device__ __forceinline__ float sigmoidf_(float x) { return __builtin_amdgcn_rcpf(1.0f + __builtin_amdgcn_exp2f(-1.4426950408889634f * x)); }
__device__ __forceinline__ float wave_sum(float v) {
#pragma unroll
    for (int o = 1; o < 64; o <<= 1) v += __shfl_xor(v, o);
    return v;
}
__device__ __forceinline__ int tid_fresh() { int t = threadIdx.x; asm volatile("" : "+v"(t)); return t; }
__device__ __forceinline__ void unpack8(const u32x4 w, float (&f)[8]) { f[0] = bf_lo(w.x); f[1] = bf_hi(w.x); f[2] = bf_lo(w.y); f[3] = bf_hi(w.y); f[4] = bf_lo(w.z); f[5] = bf_hi(w.z); f[6] = bf_lo(w.w); f[7] = bf_hi(w.w); }
__device__ __forceinline__ u32x4 pack8(const float (&f)[8]) { u32x4 w; w.x = cvt_pk_bf16(f[0], f[1]); w.y = cvt_pk_bf16(f[2], f[3]); w.z = cvt_pk_bf16(f[4], f[5]); w.w = cvt_pk_bf16(f[6], f[7]); return w; }
#define LDS_WAIT() asm volatile("s_waitcnt lgkmcnt(0)" ::: "memory")
#define VM_WAIT() asm volatile("s_waitcnt vmcnt(0)" ::: "memory")

namespace pg8 {
constexpr int BM = 256, BK = 64, HALF = 128, HTB = HALF * BK * 2, STAGE_BYTES = 8 * HTB, NXCD = 8, WGM = 8;
__host__ __device__ __forceinline__ int lds_byte(int r, int c) { const int st = (r >> 4) * 2 + (c >> 5), rr = r & 15, cc = c & 31, ob = rr * 64 + cc * 2; return st * 1024 + (ob ^ (((ob >> 9) & 1) << 5)); }
__host__ __device__ __forceinline__ void stage_rc(int b, int& R, int& C) { const int st = b / 1024, sb = b % 1024, swz = sb ^ (((sb >> 9) & 1) << 5); R = (st >> 1) * 16 + swz / 64; C = (st & 1) * 32 + (swz % 64) / 2; }
__host__ __device__ __forceinline__ int perm32(int rho) { const int n = rho >> 4, i = rho & 15; return 8 * (i >> 2) + 4 * n + (i & 3); }

struct Unit { const char* A; const char* B; int nt; int r0, c0; int aux; };

__device__ __forceinline__ bool order_tile(int i, int G, int c, int nM, int nN, int& pm, int& pn) {
    const int nwg = nM * nN; const long L = (long)i * G + c; if (L >= nwg) return false;
    int wgid = (int)L; { const int q = nwg / NXCD, r = nwg % NXCD, xcd = wgid % NXCD, off = wgid / NXCD; wgid = (xcd < r ? xcd * (q + 1) : r * (q + 1) + (xcd - r) * q) + off; }
    const int nig = WGM * nN, gid = wgid / nig, fm = gid * WGM, gsz = (nM - fm) < WGM ? (nM - fm) : WGM;
    pm = fm + ((wgid % nig) % gsz); pn = (wgid % nig) / gsz; return true;
}

template <class Epi, class Sched, bool ALIGN_EPI = true, bool SP2 = true>
__device__ __forceinline__ void gemm_phase(LAS unsigned char* lds, const Sched& S, const Epi& E, const int lda, const int ldb) {
    const int tid = tid_fresh(), wid = __builtin_amdgcn_readfirstlane(tid >> 6), lane = tid & 63, wr = wid >> 2, wc = wid & 3, fr = lane & 15, fq = lane >> 4;
    unsigned voffA[2], voffB[2];
#pragma unroll
    for (int i = 0; i < 2; ++i) { int R, C; stage_rc(tid * 16 + i * 8192, R, C); const int Rb = Epi::PERM ? ((R & ~31) + perm32(R & 31)) : R;
        voffA[i] = (unsigned)(R * lda + C) * 2u; voffB[i] = (unsigned)(Rb * ldb + C) * 2u; }
    const size_t kstep = (size_t)(BK * 2);
    const size_t hstepA = (size_t)HALF * lda * 2, hstepB = (size_t)HALF * ldb * 2;
    const unsigned ldsw = (unsigned)wid * 1024u;
    const int aoff = lds_byte(wr * 64 + fr, fq * 8), boff = lds_byte(wc * 32 + fr, fq * 8);
#define PG8_SA(b, h) (((b) * 2 + (h)) * HTB)
#define PG8_SB(b, h) ((4 + (b) * 2 + (h)) * HTB)
#define PG8_STAGE(bufoff, gbase, voff) do { _Pragma("unroll") for (int _i = 0; _i < 2; ++_i) \
        __builtin_amdgcn_global_load_lds((const unsigned*)((const char*)(gbase) + (voff)[_i]), (LAS unsigned*)(lds + (bufoff) + ldsw + _i * 8192), 16, 0, 0); } while (0)
#define PG8_LDA(dst, b, h) do { _Pragma("unroll") for (int m = 0; m < 4; ++m) _Pragma("unroll") for (int k = 0; k < 2; ++k) dst[m][k] = *(const LAS bf16x8*)(lds + PG8_SA(b, h) + aoff + m * 2048 + k * 1024); } while (0)
#define PG8_LDB(dst, b, h) do { _Pragma("unroll") for (int n = 0; n < 2; ++n) _Pragma("unroll") for (int k = 0; k < 2; ++k) dst[n][k] = *(const LAS bf16x8*)(lds + PG8_SB(b, h) + boff + n * 2048 + k * 1024); } while (0)
#define PG8_MMA(ai, bj, At, Bt) do { __builtin_amdgcn_s_setprio(1); _Pragma("unroll") for (int m = 0; m < 4; ++m) _Pragma("unroll") for (int n = 0; n < 2; ++n) _Pragma("unroll") for (int k = 0; k < 2; ++k) \
        acc[ai][bj][m][n] = __builtin_amdgcn_mfma_f32_16x16x32_bf16(Bt[n][k], At[m][k], acc[ai][bj][m][n], 0, 0, 0); __builtin_amdgcn_s_setprio(0); } while (0)
#define PG8_WAIT_V(n) asm volatile("s_waitcnt vmcnt(" #n ")" ::: "memory")
#define PG8_WAIT_L(n) asm volatile("s_waitcnt lgkmcnt(" #n ")" ::: "memory")
#define PG8_BAR __builtin_amdgcn_s_barrier()
#define PG8_SCHED __builtin_amdgcn_sched_barrier(0)
    Unit cur, nxt; int ui = 0;
    if (!S.next(0, cur)) return;
    f32x4 acc[2][2][4][2];
#pragma unroll
    for (int a = 0; a < 2; ++a)
#pragma unroll
        for (int b = 0; b < 2; ++b)
#pragma unroll
            for (int m = 0; m < 4; ++m)
#pragma unroll
                for (int n = 0; n < 2; ++n) acc[a][b][m][n] = (f32x4){0.f, 0.f, 0.f, 0.f};
    bf16x8 At[4][2], B0[2][2], B1[2][2];
    const char* cA = cur.A; const char* cB = cur.B;
    if constexpr (SP2) {
        PG8_STAGE(PG8_SB(0, 0), cB, voffB); PG8_STAGE(PG8_SB(0, 1), cB + hstepB, voffB); PG8_STAGE(PG8_SA(0, 0), cA, voffA); PG8_STAGE(PG8_SA(0, 1), cA + hstepA, voffA);
        if (wr == 1) PG8_BAR;
        PG8_WAIT_V(2); PG8_BAR;
        PG8_STAGE(PG8_SB(1, 0), cB + kstep, voffB); PG8_STAGE(PG8_SA(1, 0), cA + kstep, voffA); PG8_STAGE(PG8_SB(1, 1), cB + hstepB + kstep, voffB);
        PG8_WAIT_V(6); PG8_BAR;
    } else {
        PG8_STAGE(PG8_SB(0, 0), cB, voffB); PG8_STAGE(PG8_SA(0, 0), cA, voffA); PG8_STAGE(PG8_SB(0, 1), cB + hstepB, voffB); PG8_STAGE(PG8_SA(0, 1), cA + hstepA, voffA);
        if (wr == 1) PG8_BAR;
        PG8_WAIT_V(4); PG8_BAR;
        PG8_STAGE(PG8_SB(1, 0), cB + kstep, voffB); PG8_STAGE(PG8_SA(1, 0), cA + kstep, voffA); PG8_STAGE(PG8_SB(1, 1), cB + hstepB + kstep, voffB);
        PG8_WAIT_V(6); PG8_BAR;
    }
    for (;;) {
        const bool has_next = S.next(ui + 1, nxt);
        const char* nA = has_next ? nxt.A : cA; const char* nB = has_next ? nxt.B : cB;
        const int nt = cur.nt;
        for (int t = 0; t < nt; t += 2) {
            const bool last = (t == nt - 2);
            const char* a1 = cA + (size_t)(t + 1) * kstep;
            const char* a2 = last ? nA : cA + (size_t)(t + 2) * kstep; const char* b2 = last ? nB : cB + (size_t)(t + 2) * kstep;
            const char* a3 = a2 + kstep; const char* b3 = b2 + kstep;
            if constexpr (SP2) {
            PG8_LDB(B0, 0, 0); PG8_LDB(B1, 0, 1); PG8_SCHED; PG8_LDA(At, 0, 0); PG8_STAGE(PG8_SA(1, 1), a1 + hstepA, voffA);
            PG8_WAIT_V(8); PG8_WAIT_L(0); PG8_BAR; PG8_MMA(0, 0, At, B0); PG8_MMA(0, 1, At, B1); PG8_BAR; PG8_SCHED;
            PG8_LDA(At, 0, 1); PG8_STAGE(PG8_SB(0, 0), b2, voffB); PG8_STAGE(PG8_SB(0, 1), b2 + hstepB, voffB); PG8_STAGE(PG8_SA(0, 0), a2, voffA);
            PG8_WAIT_V(8); PG8_WAIT_L(0); PG8_BAR; PG8_MMA(1, 0, At, B0); PG8_MMA(1, 1, At, B1); PG8_BAR; PG8_SCHED;
            PG8_LDB(B0, 1, 0); PG8_LDB(B1, 1, 1); PG8_SCHED; PG8_LDA(At, 1, 0); PG8_STAGE(PG8_SA(0, 1), a2 + hstepA, voffA);
            PG8_WAIT_V(8); PG8_WAIT_L(0); PG8_BAR; PG8_MMA(0, 0, At, B0); PG8_MMA(0, 1, At, B1); PG8_BAR; PG8_SCHED;
            PG8_LDA(At, 1, 1); PG8_STAGE(PG8_SB(1, 0), b3, voffB); PG8_STAGE(PG8_SB(1, 1), b3 + hstepB, voffB); PG8_STAGE(PG8_SA(1, 0), a3, voffA);
            PG8_WAIT_V(8); PG8_WAIT_L(0); PG8_BAR; PG8_MMA(1, 0, At, B0); PG8_MMA(1, 1, At, B1); PG8_BAR; PG8_SCHED;
            } else {
            PG8_LDB(B0, 0, 0); PG8_SCHED; PG8_LDA(At, 0, 0); PG8_STAGE(PG8_SA(1, 1), a1 + hstepA, voffA);
            PG8_WAIT_L(8); PG8_BAR; PG8_WAIT_L(0); PG8_MMA(0, 0, At, B0); PG8_BAR; PG8_SCHED;
            PG8_LDB(B1, 0, 1); PG8_STAGE(PG8_SB(0, 0), b2, voffB);
            PG8_BAR; PG8_WAIT_L(0); PG8_MMA(0, 1, At, B1); PG8_BAR;
            PG8_LDA(At, 0, 1); PG8_STAGE(PG8_SA(0, 0), a2, voffA);
            PG8_BAR; PG8_WAIT_L(0); PG8_MMA(1, 0, At, B0); PG8_BAR; PG8_SCHED;
            PG8_STAGE(PG8_SB(0, 1), b2 + hstepB, voffB);
            PG8_WAIT_V(6); PG8_BAR; PG8_MMA(1, 1, At, B1); PG8_BAR;
            PG8_LDB(B0, 1, 0); PG8_SCHED; PG8_LDA(At, 1, 0); PG8_STAGE(PG8_SA(0, 1), a2 + hstepA, voffA);
            PG8_WAIT_L(8); PG8_BAR; PG8_WAIT_L(0); PG8_MMA(0, 0, At, B0); PG8_BAR; PG8_SCHED;
            PG8_LDB(B1, 1, 1); PG8_STAGE(PG8_SB(1, 0), b3, voffB);
            PG8_BAR; PG8_WAIT_L(0); PG8_MMA(0, 1, At, B1); PG8_BAR;
            PG8_LDA(At, 1, 1); PG8_STAGE(PG8_SA(1, 0), a3, voffA);
            PG8_BAR; PG8_WAIT_L(0); PG8_MMA(1, 0, At, B0); PG8_BAR; PG8_SCHED;
            PG8_STAGE(PG8_SB(1, 1), b3 + hstepB, voffB);
            PG8_WAIT_V(6); PG8_BAR; PG8_MMA(1, 1, At, B1); PG8_BAR;
            }
        }
        if constexpr (ALIGN_EPI) { if (wr == 0) PG8_BAR; }
        const bool keep = E(acc, cur, wr, wc, fr, fq);
        if (!has_next) break;
        if (!keep) {
#pragma unroll
        for (int a = 0; a < 2; ++a)
#pragma unroll
            for (int b = 0; b < 2; ++b)
#pragma unroll
                for (int m = 0; m < 4; ++m)
#pragma unroll
                    for (int n = 0; n < 2; ++n) acc[a][b][m][n] = (f32x4){0.f, 0.f, 0.f, 0.f};
        }
        cur = nxt; cA = nA; cB = nB; ++ui;
        if constexpr (ALIGN_EPI) { if (wr == 1) PG8_BAR; }
    }
    PG8_WAIT_V(0);
    if constexpr (!ALIGN_EPI) { if (wr == 0) PG8_BAR; }
    PG8_BAR;
#undef PG8_SA
#undef PG8_SB
#undef PG8_STAGE
#undef PG8_LDA
#undef PG8_LDB
#undef PG8_MMA
#undef PG8_WAIT_V
#undef PG8_WAIT_L
#undef PG8_BAR
#undef PG8_SCHED
}

struct TileSched {
    const char* A; const char* B; size_t lda2, ldb2; int nt, mode, nMv, nN, c0base, G, c;
    __device__ __forceinline__ void init(const void* A_, int lda, const void* B_, int ldb, int K, int mode_, int nN_, int c0base_, int G_, int c_) {
        A = (const char*)A_; B = (const char*)B_; lda2 = (size_t)lda * 2; ldb2 = (size_t)ldb * 2; nt = K / 64; mode = mode_; nMv = mode_ == 0 ? 66 : (mode_ == 1 ? 64 : 2); nN = nN_; c0base = c0base_; G = G_; c = c_; }
    __device__ __forceinline__ int units() const { return nMv * nN; }
    __device__ __forceinline__ bool next(int i, Unit& u) const {
        int vm, pn; if (!order_tile(i, G, c, nMv, nN, vm, pn)) return false;
        const int pm = mode == 0 ? vm : (mode == 1 ? vm + 1 + (vm >= 32 ? 1 : 0) : vm * TPB);
        u.A = A + (size_t)pm * 256 * lda2; u.B = B + (size_t)pn * 256 * ldb2; u.nt = nt; u.r0 = pm * 256; u.c0 = c0base + pn * 256; u.aux = 0; return true; }
};
struct MergeSched {
    const char* A; const char* B; int mode, nMv, G, c;
    __device__ __forceinline__ bool next(int i, Unit& u) const {
        const int ti = i / 3, k = i - ti * 3; int vm, pn; if (!order_tile(ti, G, c, nMv, 16, vm, pn)) return false;
        const int pm = mode == 0 ? vm : vm + 1 + (vm >= 32 ? 1 : 0);
        const int p = c % 6, s0 = p >> 1, r = p & 1, s1 = s0 == 0 ? (r ? 2 : 1) : (s0 == 1 ? (r ? 2 : 0) : (r ? 1 : 0)), s2 = 3 - s0 - s1;
        const int seg = k == 0 ? s0 : (k == 1 ? s1 : s2), nxt = k == 0 ? s1 : (k == 1 ? s2 : 3);
        const int koff = seg == 0 ? 0 : (seg == 1 ? 1024 : 3072);
        u.A = A + ((size_t)pm * 256 * 4096 + koff) * 2; u.B = B + ((size_t)pn * 256 * 4096 + koff) * 2; u.nt = seg == 1 ? 32 : 16; u.r0 = pm * 256; u.c0 = pn * 256; u.aux = seg * 4 + nxt; return true; }
};
struct CtxSplitSched {
    const char* A; const char* B; int merge, G, c;
    __device__ __forceinline__ bool next(int i, Unit& u) const {
        const long L = (long)i * G + c; if (L >= 256) return false;
        const int t = (int)L >> 3, ch = (int)L & 7, pmc = t >> 4, pn = t & 15, pm = pmc * TPB, koff = ch * 512;
        u.A = A + ((size_t)pm * 256 * 4096 + koff) * 2; u.B = B + ((size_t)pn * 256 * 4096 + koff) * 2; u.nt = 8; u.r0 = pmc * 256; u.c0 = pn * 256;
        u.aux = ch * 4 + (merge ? (ch < 2 ? 0 : (ch < 6 ? 1 : 2)) : 0); return true; }
};
struct CswSched {
    const char* WfnT; const char* CS; int G, c;
    __device__ __forceinline__ bool next(int i, Unit& u) const {
        const long L = (long)i * G + c; if (L >= 32) return false;
        const int pm = (int)L >> 3, pn = (int)L & 7;
        u.A = WfnT + (size_t)pm * 256 * 1024 * 2; u.B = CS + (size_t)pn * 256 * 1024 * 2; u.nt = 16; u.r0 = (pn >> 2) * 1024 + pm * 256; u.c0 = (pn & 3) * 256; u.aux = 0; return true; }
};
struct FchanSched {
    const char* CS; const char* EO; int G, c;
    __device__ __forceinline__ bool next(int i, Unit& u) const {
        const long L = (long)i * G + c; if (L >= 256) return false;
        const int j = (int)L >> 5, r = (int)L & 31, sn = (j >> 1) & 1, pmm = r >> 3, pns = r & 7;
        u.A = CS + (size_t)(sn * 1024 + pmm * 256) * 1024 * 2; u.B = EO + (size_t)(j * 2048 + pns * 256) * 1024 * 2; u.nt = 16;
        u.r0 = sn * 1024 + pmm * 256; u.c0 = j * 2048 + pns * 256; u.aux = 0; return true; }
};
struct FchanCtxSched {
    const char* CS; const char* Z; int G, c;
    __device__ __forceinline__ bool next(int i, Unit& u) const {
        const long L = (long)i * G + c; if (L >= 16) return false;
        const int b = (int)L >> 3, p8 = (int)L & 7;
        u.A = CS + (size_t)p8 * 256 * 1024 * 2; u.B = Z + ((size_t)b * SB * NZ + ZC_F) * 2; u.nt = 16;
        u.r0 = b * 1024 + (p8 & 3) * 256; u.c0 = (p8 >> 2) * 256; u.aux = 0; return true; }
};
struct FseqSched {
    const char* ws; int G, c;
    __device__ __forceinline__ bool next(int i, Unit& u) const {
        const long L = (long)i * G + c; if (L >= 256) return false;
        const int j = (int)L >> 5, r = (int)L & 31, a = j & 3, sn = a >> 1, pk = r >> 2, pmm = r & 3;
        u.A = ws + WS_COS + (size_t)a * (8 * MiB) + (size_t)pk * 256 * 2048 * 2; u.B = ws + WS_ECOS + ((size_t)(sn * 1024 + pmm * 256) * 16384 + (size_t)j * 2048) * 2; u.nt = 32;
        u.r0 = j * 2048 + pk * 256; u.c0 = pmm * 256; u.aux = 0; return true; }
};
struct FseqCtxSched {
    const char* CS256; const char* TCT; int G, c;
    __device__ __forceinline__ bool next(int i, Unit& u) const {
        const long L = (long)i * G + c; if (L >= 8) return false;
        const int b = (int)L >> 2, pmm = (int)L & 3;
        u.A = CS256; u.B = TCT + (size_t)(b * 1024 + pmm * 256) * 512 * 2; u.nt = 8; u.r0 = b * SB; u.c0 = pmm * 256; u.aux = 0; return true; }
};

__device__ __forceinline__ int zact_of_tile(int pn) {
    if (pn < 4) return 0; if (pn < 8) return 1; if (pn < 14) return 0; if (pn < 22) return 1; if (pn < 26) return 0; if (pn < 30) return 2; if (pn < 34) return 1; return 2; }

struct EpiZ {
    static constexpr bool PERM = true;
    bf16_t* Z;
    __device__ __forceinline__ bool operator()(f32x4 (&acc)[2][2][4][2], const Unit& u, int wr, int wc, int fr, int fq) const {
        const int kind = zact_of_tile(u.c0 >> 8);
        const int row0 = u.r0 + wr * 64 + fr, col0 = u.c0 + wc * 32 + 8 * fq;
#pragma unroll
        for (int ai = 0; ai < 2; ++ai)
#pragma unroll
            for (int m = 0; m < 4; ++m) { bf16_t* rowp = Z + (size_t)(row0 + ai * HALF + m * 16) * NZ + col0;
#pragma unroll
                for (int bj = 0; bj < 2; ++bj) { f32x4 v0 = acc[ai][bj][m][0], v1 = acc[ai][bj][m][1];
                    if (kind) {
#pragma unroll
                        for (int j = 0; j < 4; ++j) { const float s0 = sigmoidf_(v0[j]), s1 = sigmoidf_(v1[j]); v0[j] = kind == 1 ? v0[j] * s0 : s0; v1[j] = kind == 1 ? v1[j] * s1 : s1; } }
                    u32x4 w; w.x = cvt_pk_bf16(v0[0], v0[1]); w.y = cvt_pk_bf16(v0[2], v0[3]); w.z = cvt_pk_bf16(v1[0], v1[1]); w.w = cvt_pk_bf16(v1[2], v1[3]);
                    *(u32x4*)(rowp + bj * HALF) = w; } }
        return false;
    }
};
struct EpiBf16 {
    static constexpr bool PERM = true;
    bf16_t* O; int ldc; float scale;
    __device__ __forceinline__ bool operator()(f32x4 (&acc)[2][2][4][2], const Unit& u, int wr, int wc, int fr, int fq) const {
        const int row0 = u.r0 + wr * 64 + fr, col0 = u.c0 + wc * 32 + 8 * fq;
#pragma unroll
        for (int ai = 0; ai < 2; ++ai)
#pragma unroll
            for (int m = 0; m < 4; ++m) { bf16_t* rowp = O + (size_t)(row0 + ai * HALF + m * 16) * ldc + col0;
#pragma unroll
                for (int bj = 0; bj < 2; ++bj) { const f32x4 v0 = acc[ai][bj][m][0] * scale, v1 = acc[ai][bj][m][1] * scale;
                    u32x4 w; w.x = cvt_pk_bf16(v0[0], v0[1]); w.y = cvt_pk_bf16(v0[2], v0[3]); w.z = cvt_pk_bf16(v1[0], v1[1]); w.w = cvt_pk_bf16(v1[2], v1[3]);
                    *(u32x4*)(rowp + bj * HALF) = w; } }
        return false;
    }
};
struct EpiGate {
    static constexpr bool PERM = true;
    bf16_t* Y; const bf16_t* Z; int ycol, gcol; float scale;
    __device__ __forceinline__ bool operator()(f32x4 (&acc)[2][2][4][2], const Unit& u, int wr, int wc, int fr, int fq) const {
        const int row0 = u.r0 + wr * 64 + fr, col0 = u.c0 + wc * 32 + 8 * fq;
        u32x4 g[2][4][2];
#pragma unroll
        for (int ai = 0; ai < 2; ++ai)
#pragma unroll
            for (int m = 0; m < 4; ++m) { const size_t r = (size_t)(row0 + ai * HALF + m * 16);
#pragma unroll
                for (int bj = 0; bj < 2; ++bj) g[ai][m][bj] = *(const u32x4*)(Z + r * NZ + gcol + col0 + bj * HALF); }
        __builtin_amdgcn_sched_barrier(0);
#pragma unroll
        for (int ai = 0; ai < 2; ++ai)
#pragma unroll
            for (int m = 0; m < 4; ++m) { const size_t r = (size_t)(row0 + ai * HALF + m * 16);
#pragma unroll
                for (int bj = 0; bj < 2; ++bj) { const u32x4 gg = g[ai][m][bj];
                    const f32x4 v0 = acc[ai][bj][m][0] * scale, v1 = acc[ai][bj][m][1] * scale;
                    u32x4 w; w.x = cvt_pk_bf16(v0[0] * bf_lo(gg.x), v0[1] * bf_hi(gg.x)); w.y = cvt_pk_bf16(v0[2] * bf_lo(gg.y), v0[3] * bf_hi(gg.y));
                    w.z = cvt_pk_bf16(v1[0] * bf_lo(gg.z), v1[1] * bf_hi(gg.z)); w.w = cvt_pk_bf16(v1[2] * bf_lo(gg.w), v1[3] * bf_hi(gg.w));
                    *(u32x4*)(Y + r * 4096 + ycol + col0 + bj * HALF) = w; } }
        return false;
    }
};
struct EpiF32 {
    static constexpr bool PERM = false;
    float* C; int ldc;
    __device__ __forceinline__ bool operator()(f32x4 (&acc)[2][2][4][2], const Unit& u, int wr, int wc, int fr, int fq) const {
        const int row0 = u.r0 + wr * 64 + fr, col0 = u.c0 + wc * 32 + 4 * fq;
#pragma unroll
        for (int ai = 0; ai < 2; ++ai)
#pragma unroll
            for (int m = 0; m < 4; ++m) { float* rowp = C + (size_t)(row0 + ai * HALF + m * 16) * ldc + col0;
#pragma unroll
                for (int bj = 0; bj < 2; ++bj)
#pragma unroll
                    for (int n = 0; n < 2; ++n) *(f32x4*)(rowp + bj * HALF + n * 16) = acc[ai][bj][m][n]; }
        return false;
    }
};
struct EpiMerge {
    static constexpr bool PERM = true;
    bf16_t* O; const bf16_t* Z;
    __device__ __forceinline__ bool operator()(f32x4 (&acc)[2][2][4][2], const Unit& u, int wr, int wc, int fr, int fq) const {
        const int row0 = u.r0 + wr * 64 + fr, col0 = u.c0 + wc * 32 + 8 * fq; const int cur = u.aux >> 2, nxt = u.aux & 3; const bool last = nxt == 3;
        const int gnum = cur == 0 ? ZC_MF : (cur == 1 ? ZC_MM : ZC_MC), gden = nxt == 0 ? ZC_MF : (nxt == 1 ? ZC_MM : ZC_MC);
#pragma unroll
        for (int ai = 0; ai < 2; ++ai) {
            u32x4 gn[4][2], gd[4][2];
#pragma unroll
            for (int m = 0; m < 4; ++m)
#pragma unroll
                for (int bj = 0; bj < 2; ++bj) { const size_t r = (size_t)(row0 + ai * HALF + m * 16);
                    gn[m][bj] = *(const u32x4*)(Z + r * NZ + gnum + col0 + bj * HALF);
                    gd[m][bj] = last ? (u32x4){0x3f803f80u, 0x3f803f80u, 0x3f803f80u, 0x3f803f80u} : *(const u32x4*)(Z + r * NZ + gden + col0 + bj * HALF); }
            __builtin_amdgcn_sched_barrier(0);
#pragma unroll
            for (int m = 0; m < 4; ++m)
#pragma unroll
                for (int bj = 0; bj < 2; ++bj) { const size_t r = (size_t)(row0 + ai * HALF + m * 16);
                    const u32x4 a = gn[m][bj], d = gd[m][bj];
                    float f[8] = {bf_lo(a.x), bf_hi(a.x), bf_lo(a.y), bf_hi(a.y), bf_lo(a.z), bf_hi(a.z), bf_lo(a.w), bf_hi(a.w)};
                    if (!last) { const float dd[8] = {bf_lo(d.x), bf_hi(d.x), bf_lo(d.y), bf_hi(d.y), bf_lo(d.z), bf_hi(d.z), bf_lo(d.w), bf_hi(d.w)};
#pragma unroll
                        for (int j = 0; j < 8; ++j) f[j] = f[j] * __builtin_amdgcn_rcpf(fmaxf(dd[j], 1e-30f)); }
                    f32x4 v0 = acc[ai][bj][m][0], v1 = acc[ai][bj][m][1];
#pragma unroll
                    for (int j = 0; j < 4; ++j) { v0[j] *= f[j]; v1[j] *= f[4 + j]; }
                    if (!last) { acc[ai][bj][m][0] = v0; acc[ai][bj][m][1] = v1; }
                    else { u32x4 w; w.x = cvt_pk_bf16(v0[0], v0[1]); w.y = cvt_pk_bf16(v0[2], v0[3]); w.z = cvt_pk_bf16(v1[0], v1[1]); w.w = cvt_pk_bf16(v1[2], v1[3]);
                        *(u32x4*)(O + r * 4096 + col0 + bj * HALF) = w; } }
            __builtin_amdgcn_sched_barrier(0);
        }
        return !last;
    }
};
struct EpiMergePart {
    static constexpr bool PERM = true;
    float* PART; const bf16_t* Z;
    __device__ __forceinline__ bool operator()(f32x4 (&acc)[2][2][4][2], const Unit& u, int wr, int wc, int fr, int fq) const {
        const int ch = u.aux >> 2, seg = u.aux & 3, gcol = seg == 0 ? ZC_MF : (seg == 1 ? ZC_MM : ZC_MC);
        const int pmc = u.r0 >> 8; const size_t zrow0 = (size_t)pmc * SB;
        const int rl0 = wr * 64 + fr, col0 = u.c0 + wc * 32 + 8 * fq;
        float* P = PART + ((size_t)ch * 512 + u.r0) * 4096;
        u32x4 g[2][4][2];
#pragma unroll
        for (int ai = 0; ai < 2; ++ai)
#pragma unroll
            for (int m = 0; m < 4; ++m)
#pragma unroll
                for (int bj = 0; bj < 2; ++bj) g[ai][m][bj] = *(const u32x4*)(Z + (zrow0 + rl0 + ai * HALF + m * 16) * NZ + gcol + col0 + bj * HALF);
        __builtin_amdgcn_sched_barrier(0);
#pragma unroll
        for (int ai = 0; ai < 2; ++ai)
#pragma unroll
            for (int m = 0; m < 4; ++m)
#pragma unroll
                for (int bj = 0; bj < 2; ++bj) { const u32x4 gg = g[ai][m][bj]; const f32x4 v0 = acc[ai][bj][m][0], v1 = acc[ai][bj][m][1];
                    float* dst = P + (size_t)(rl0 + ai * HALF + m * 16) * 4096 + col0 + bj * HALF;
                    *(f32x4*)dst = (f32x4){v0[0] * bf_lo(gg.x), v0[1] * bf_hi(gg.x), v0[2] * bf_lo(gg.y), v0[3] * bf_hi(gg.y)};
                    *(f32x4*)(dst + 4) = (f32x4){v1[0] * bf_lo(gg.z), v1[1] * bf_hi(gg.z), v1[2] * bf_lo(gg.w), v1[3] * bf_hi(gg.w)}; }
        return false;
    }
};
struct EpiOutPart {
    static constexpr bool PERM = false;
    float* PART; const float* mod;
    __device__ __forceinline__ bool operator()(f32x4 (&acc)[2][2][4][2], const Unit& u, int wr, int wc, int fr, int fq) const {
        const int ch = u.aux >> 2; const float* gate = mod + (size_t)2 * 12288 + 2 * DM;
        const int rl0 = wr * 64 + fr, col0 = u.c0 + wc * 32 + 4 * fq;
        float* P = PART + ((size_t)ch * 512 + u.r0) * 4096;
#pragma unroll
        for (int bj = 0; bj < 2; ++bj)
#pragma unroll
            for (int n = 0; n < 2; ++n) { const f32x4 gv = *(const f32x4*)(gate + col0 + bj * HALF + n * 16);
#pragma unroll
                for (int ai = 0; ai < 2; ++ai)
#pragma unroll
                    for (int m = 0; m < 4; ++m) *(f32x4*)(P + (size_t)(rl0 + ai * HALF + m * 16) * 4096 + col0 + bj * HALF + n * 16) = gv * acc[ai][bj][m][n]; }
        return false;
    }
};
struct EpiOut {
    static constexpr bool PERM = false;
    const float* xl_old; const float* xc_old; float* xl_new; float* xc_new; const float* mod;
    __device__ __forceinline__ bool operator()(f32x4 (&acc)[2][2][4][2], const Unit& u, int wr, int wc, int fr, int fq) const {
        const int pm = u.r0 >> 8, b = pm / TPB, pt = pm - b * TPB; const bool isctx = pt == 0;
        const float* src = isctx ? xc_old + (size_t)b * CTX * DM : xl_old + ((size_t)b * SEQ + (size_t)(pt - 1) * 256) * DM;
        float* dst = isctx ? xc_new + (size_t)b * CTX * DM : xl_new + ((size_t)b * SEQ + (size_t)(pt - 1) * 256) * DM;
        const float* gate = mod + (size_t)(isctx ? 2 : b) * 12288 + 2 * DM;
        const int row0 = wr * 64 + fr, col0 = u.c0 + wc * 32 + 4 * fq;
        f32x4 gv[2][2];
#pragma unroll
        for (int bj = 0; bj < 2; ++bj)
#pragma unroll
            for (int n = 0; n < 2; ++n) gv[bj][n] = *(const f32x4*)(gate + col0 + bj * HALF + n * 16);
#pragma unroll
        for (int ai = 0; ai < 2; ++ai) {
            f32x4 xo[4][2][2];
#pragma unroll
            for (int m = 0; m < 4; ++m) { const size_t off = (size_t)(row0 + ai * HALF + m * 16) * DM + col0;
#pragma unroll
                for (int bj = 0; bj < 2; ++bj)
#pragma unroll
                    for (int n = 0; n < 2; ++n) xo[m][bj][n] = *(const f32x4*)(src + off + bj * HALF + n * 16); }
#pragma unroll
            for (int m = 0; m < 4; ++m)
#pragma unroll
                for (int bj = 0; bj < 2; ++bj)
#pragma unroll
                    for (int n = 0; n < 2; ++n) acc[ai][bj][m][n] = xo[m][bj][n] + gv[bj][n] * acc[ai][bj][m][n];
        }
#pragma unroll
        for (int ai = 0; ai < 2; ++ai)
#pragma unroll
            for (int m = 0; m < 4; ++m) { const size_t off = (size_t)(row0 + ai * HALF + m * 16) * DM + col0;
#pragma unroll
                for (int bj = 0; bj < 2; ++bj)
#pragma unroll
                    for (int n = 0; n < 2; ++n) *(f32x4*)(dst + off + bj * HALF + n * 16) = acc[ai][bj][m][n]; }
        return false;
    }
};
}

namespace att {
constexpr int NW = 8, QBLK = 32, KVBLK = 64;
constexpr float SCALE = 0.07216878364870322f;
constexpr float THR = 8.f;
constexpr int LDQ = 3072, LDK = 3072, LDV = 4096;
constexpr int SHM_V = KVBLK * DVH * 2, SHM_K = KVBLK * DQK * 2;
constexpr int SHM_QR = 2 * SHM_V + 2 * SHM_K + NW * 64 * 4;
constexpr int SHM_ATTN = SHM_QR + NW * 4096;
#ifndef ATT_SDEPTH
#define ATT_SDEPTH 1
#endif
constexpr int SDEPTH = ATT_SDEPTH;
#define KSWZ(row, colB) ((row) * 384 + ((colB) ^ ((((row) >> 1) & 7) << 4)))
#define SBAR() __builtin_amdgcn_sched_barrier(0)
__device__ __forceinline__ int crow(int r, int hi) { return (r & 3) + 8 * (r >> 2) + 4 * hi; }
__device__ __forceinline__ void partialSM(f32x16& p0, f32x16& p1, float& m_reg, float& mn, float& alpha) {
  constexpr float C = SCALE * 1.4426950408889634f;
  float pmax = p0[0];
#pragma unroll
  for (int r = 1; r < 16; ++r) pmax = fmaxf(pmax, p0[r]);
#pragma unroll
  for (int r = 0; r < 16; ++r) pmax = fmaxf(pmax, p1[r]);
  { auto rr = __builtin_amdgcn_permlane32_swap(__float_as_uint(pmax), __float_as_uint(pmax), false, false);
    pmax = fmaxf(__uint_as_float(rr[0]), __uint_as_float(rr[1])); }
  if (__builtin_expect(__all(pmax - m_reg <= THR / SCALE), 1)) { mn = m_reg; alpha = 1.f; }
  else { mn = fmaxf(m_reg, pmax); alpha = __builtin_amdgcn_exp2f((m_reg - mn) * C); m_reg = mn; }
  float mnC = -mn * C;
#pragma unroll
  for (int r = 0; r < 16; ++r) p0[r] = fmaf(p0[r], C, mnC);
#pragma unroll
  for (int r = 0; r < 16; ++r) p1[r] = fmaf(p1[r], C, mnC);
#pragma unroll
  for (int r = 0; r < 16; ++r) p0[r] = __builtin_amdgcn_exp2f(p0[r]);
}
__device__ __forceinline__ void partialSM_fix(f32x16& p0, f32x16& p1) {
#pragma unroll
  for (int r = 0; r < 16; ++r) p0[r] = __builtin_amdgcn_exp2f(p0[r]);
}
__device__ __forceinline__ void finishSM_fix(f32x16& p0, f32x16& p1, float& l_lane, bf16x8& pa0, bf16x8& pa1, bf16x8& pa2, bf16x8& pa3) {
#pragma unroll
  for (int r = 0; r < 16; ++r) p1[r] = __builtin_amdgcn_exp2f(p1[r]);
  float ps = 0;
#pragma unroll
  for (int r = 0; r < 16; ++r) ps += p0[r];
#pragma unroll
  for (int r = 0; r < 16; ++r) ps += p1[r];
  l_lane += ps;
#define PK4(P, BASE, OUT) do { unsigned a0 = cvt_pk_bf16(P[BASE + 0], P[BASE + 1]), a1 = cvt_pk_bf16(P[BASE + 2], P[BASE + 3]);   \
    unsigned b0 = cvt_pk_bf16(P[BASE + 4], P[BASE + 5]), b1 = cvt_pk_bf16(P[BASE + 6], P[BASE + 7]);                              \
    auto r0 = __builtin_amdgcn_permlane32_swap(a0, b0, false, false); auto r1 = __builtin_amdgcn_permlane32_swap(a1, b1, false, false); \
    u32x4 w = {r0[0], r1[0], r0[1], r1[1]}; OUT = *reinterpret_cast<bf16x8*>(&w); } while (0)
  PK4(p0, 0, pa0); PK4(p0, 8, pa1); PK4(p1, 0, pa2); PK4(p1, 8, pa3);
#undef PK4
}
__device__ __forceinline__ void finishSM(f32x16& p0, f32x16& p1, float alpha, float& l_reg, bf16x8& pa0, bf16x8& pa1, bf16x8& pa2, bf16x8& pa3) {
#pragma unroll
  for (int r = 0; r < 16; ++r) p1[r] = __builtin_amdgcn_exp2f(p1[r]);
  float ps = 0;
#pragma unroll
  for (int r = 0; r < 16; ++r) ps += p0[r];
#pragma unroll
  for (int r = 0; r < 16; ++r) ps += p1[r];
  { auto rr = __builtin_amdgcn_permlane32_swap(__float_as_uint(ps), __float_as_uint(ps), false, false);
    ps = __uint_as_float(rr[0]) + __uint_as_float(rr[1]); }
  l_reg = l_reg * alpha + ps;
#define PK4(P, BASE, OUT) do { unsigned a0 = cvt_pk_bf16(P[BASE + 0], P[BASE + 1]), a1 = cvt_pk_bf16(P[BASE + 2], P[BASE + 3]);   \
    unsigned b0 = cvt_pk_bf16(P[BASE + 4], P[BASE + 5]), b1 = cvt_pk_bf16(P[BASE + 6], P[BASE + 7]);                              \
    auto r0 = __builtin_amdgcn_permlane32_swap(a0, b0, false, false); auto r1 = __builtin_amdgcn_permlane32_swap(a1, b1, false, false); \
    u32x4 w = {r0[0], r1[0], r0[1], r1[1]}; OUT = *reinterpret_cast<bf16x8*>(&w); } while (0)
  PK4(p0, 0, pa0); PK4(p0, 8, pa1); PK4(p1, 0, pa2); PK4(p1, 8, pa3);
#undef PK4
}
__device__ __forceinline__ void qkt(f32x16& p0, f32x16& p1, const char* Ks, const bf16x8 (&qr)[8], const char* qrope, const int (&kb)[4]) {
  p0 = f32x16{}; p1 = f32x16{};
#define KLD(d, half) (*reinterpret_cast<const bf16x8*>(Ks + kb[(d) & 3] + ((d) >> 2) * 128 + (half) * (32 * 384)))
  bf16x8 c0 = KLD(0, 0), c1 = KLD(0, 1), cq = qr[0];
#pragma unroll
  for (int d0 = 0; d0 < 12; ++d0) {
    bf16x8 n0 = c0, n1 = c1, nq = cq;
    if (d0 < 11) { n0 = KLD(d0 + 1, 0); n1 = KLD(d0 + 1, 1); nq = (d0 + 1 < 8) ? qr[(d0 + 1 < 8) ? d0 + 1 : 0] : *reinterpret_cast<const bf16x8*>(qrope + (d0 + 1 - 8) * 1024); }
    __builtin_amdgcn_sched_group_barrier(0x100, 3, 0);
    p0 = __builtin_amdgcn_mfma_f32_32x32x16_bf16(c0, cq, p0, 0, 0, 0);
    p1 = __builtin_amdgcn_mfma_f32_32x32x16_bf16(c1, cq, p1, 0, 0, 0);
    __builtin_amdgcn_sched_group_barrier(0x008, 2, 0);
    c0 = n0; c1 = n1; cq = nq; }
#undef KLD
}
__device__ __forceinline__ int v_st(int k, int c) { const int kk = (k & ~0xC) | ((k & 4) << 1) | ((k & 8) >> 1); return ((kk >> 3) * 4 + (c >> 5)) * 512 + ((kk & 7) * 32 + (c & 31)) * 2; }
__device__ __forceinline__ int v_rd_base(int lane) { return ((lane & 3) << 3) | (((lane >> 2) & 3) << 6) | (((lane >> 4) & 1) << 5) | (((lane >> 5) & 1) << 8); }
constexpr int v_rd_off(int d0, int ks, int half) { return d0 * 512 + ks * 4096 + half * 2048; }
template <int OFF> __device__ __forceinline__ s16x4 tr_read(int vb) {
  s16x4 r; asm volatile("ds_read_b64_tr_b16 %0, %1 offset:%2" : "=&v"(r) : "v"(vb), "i"(OFF) : "memory"); return r;
}
template <int D0> __device__ __forceinline__ void pv_one(f32x16& od, int vb, bf16x8 pa0, bf16x8 pa1, bf16x8 pa2, bf16x8 pa3) {
  const s16x4 l0 = tr_read<v_rd_off(D0, 0, 0)>(vb), h0 = tr_read<v_rd_off(D0, 0, 1)>(vb), l1 = tr_read<v_rd_off(D0, 1, 0)>(vb), h1 = tr_read<v_rd_off(D0, 1, 1)>(vb);
  const s16x4 l2 = tr_read<v_rd_off(D0, 2, 0)>(vb), h2 = tr_read<v_rd_off(D0, 2, 1)>(vb), l3 = tr_read<v_rd_off(D0, 3, 0)>(vb), h3 = tr_read<v_rd_off(D0, 3, 1)>(vb);
  asm volatile("s_waitcnt lgkmcnt(0)" ::: "memory"); SBAR();
#define PK(L, H) (bf16x8){L[0], L[1], L[2], L[3], H[0], H[1], H[2], H[3]}
  od = __builtin_amdgcn_mfma_f32_32x32x16_bf16(pa0, PK(l0, h0), od, 0, 0, 0);
  od = __builtin_amdgcn_mfma_f32_32x32x16_bf16(pa1, PK(l1, h1), od, 0, 0, 0);
  od = __builtin_amdgcn_mfma_f32_32x32x16_bf16(pa2, PK(l2, h2), od, 0, 0, 0);
  od = __builtin_amdgcn_mfma_f32_32x32x16_bf16(pa3, PK(l3, h3), od, 0, 0, 0);
#undef PK
}
__device__ __forceinline__ void pv_d0(f32x16 (&o)[4], int vb, bf16x8 pa0, bf16x8 pa1, bf16x8 pa2, bf16x8 pa3) {
  pv_one<0>(o[0], vb, pa0, pa1, pa2, pa3); pv_one<1>(o[1], vb, pa0, pa1, pa2, pa3); pv_one<2>(o[2], vb, pa0, pa1, pa2, pa3); pv_one<3>(o[3], vb, pa0, pa1, pa2, pa3);
}

__device__ __forceinline__ void attn_unit(const bf16_t* __restrict__ Qb, const bf16_t* __restrict__ Kh, const bf16_t* __restrict__ Vh, int seq, char* lds,
                                          const bf16_t* __restrict__ gate, bf16_t* __restrict__ Yo) {
  const int tid = tid_fresh(), wid = tid >> 6, lane = tid & 63, r32 = lane & 31, hi = lane >> 5;
  char* V_lds = lds; char* K_lds = lds + 2 * SHM_V;
  float* ws = (float*)(lds + 2 * SHM_V + 2 * SHM_K) + wid * 64; float* li_l = ws; float* al_l = ws + 32;
  float m_reg = -1e30f, l_reg = 0; f32x16 o[4] = {}; bf16x8 qr[8];
  const bf16_t* Qw = Qb + (long)(wid * QBLK + r32) * LDQ + hi * 8;
  char* qrope = lds + SHM_QR + wid * 4096 + lane * 16;
  int kb[4];
#pragma unroll
  for (int d = 0; d < 4; ++d) kb[d] = r32 * 384 + (((d * 2 + hi) ^ ((r32 >> 1) & 7)) << 4);
#pragma unroll
  for (int d0 = 0; d0 < 8; ++d0) qr[d0] = *reinterpret_cast<const bf16x8*>(Qw + d0 * 16);
#pragma unroll
  for (int d0 = 8; d0 < 12; ++d0) *reinterpret_cast<bf16x8*>(qrope + (d0 - 8) * 1024) = *reinterpret_cast<const bf16x8*>(Qw + d0 * 16);
  const int sr = tid >> 4, sc = (tid & 15) * 8, vst0 = v_st(sr, sc), vst1 = v_st(32 + sr, sc);
  unsigned kvo[3], klo[3];
#pragma unroll
  for (int i = 0; i < 3; ++i) { const int q = tid + 512 * i, kr = q / 24, kc = q - kr * 24; kvo[i] = (unsigned)(kr * LDK + kc * 8) * 2u; klo[i] = (unsigned)KSWZ(kr, kc * 16); }
  const unsigned vvo0 = (unsigned)(sr * LDV + sc) * 2u, vvo1 = (unsigned)((32 + sr) * LDV + sc) * 2u;
  const int vb0 = (int)(uintptr_t)V_lds + v_rd_base(lane);
  struct { bf16x8 vs0, vs1, ks0, ks1, ks2; } sr_[SDEPTH];
#define SLOAD(i, k0) do { const char* Vt_ = (const char*)Vh + (size_t)(k0) * (LDV * 2); const char* Kt_ = (const char*)Kh + (size_t)(k0) * (LDK * 2); \
    sr_[i].vs0 = *reinterpret_cast<const bf16x8*>(Vt_ + vvo0); sr_[i].vs1 = *reinterpret_cast<const bf16x8*>(Vt_ + vvo1); \
    sr_[i].ks0 = *reinterpret_cast<const bf16x8*>(Kt_ + kvo[0]); sr_[i].ks1 = *reinterpret_cast<const bf16x8*>(Kt_ + kvo[1]); sr_[i].ks2 = *reinterpret_cast<const bf16x8*>(Kt_ + kvo[2]); } while (0)
#define SWRITE(b, i) do { *(bf16x8*)(V_lds + (b) * SHM_V + vst0) = sr_[i].vs0; *(bf16x8*)(V_lds + (b) * SHM_V + vst1) = sr_[i].vs1; \
    *(bf16x8*)(K_lds + (b) * SHM_K + klo[0]) = sr_[i].ks0; *(bf16x8*)(K_lds + (b) * SHM_K + klo[1]) = sr_[i].ks1; *(bf16x8*)(K_lds + (b) * SHM_K + klo[2]) = sr_[i].ks2; } while (0)
#define SWAIT() do { if constexpr (SDEPTH == 2) asm volatile("s_waitcnt vmcnt(5)" ::: "memory"); else asm volatile("s_waitcnt vmcnt(0)" ::: "memory"); } while (0)
#define RESC(a) do { if (__any((a) < 1.f)) { if (hi == 0) al_l[r32] = (a); asm volatile("s_waitcnt lgkmcnt(0)" ::: "memory"); \
    _Pragma("unroll") for (int d = 0; d < 4; ++d) _Pragma("unroll") for (int r = 0; r < 16; ++r) o[d][r] *= al_l[crow(r, hi)]; } } while (0)
  f32x16 pA0, pA1, pB0, pB1; float mnA, mnB, alA, alB; bf16x8 pa0, pa1, pa2, pa3; const int NT = seq / KVBLK;
  constexpr int SE = 0, SO = SDEPTH - 1;
  SLOAD(SE, 0); asm volatile("s_waitcnt vmcnt(0)" ::: "memory"); SWRITE(0, SE); __syncthreads();
  qkt(pA0, pA1, K_lds, qr, qrope, kb); partialSM(pA0, pA1, m_reg, mnA, alA);
  SLOAD(SO, KVBLK); if constexpr (SDEPTH == 2) { if (2 < NT) SLOAD(SE, 2 * KVBLK); }
  SWAIT(); SWRITE(1, SO); __syncthreads();
  for (int j = 1; j + 1 < NT; j += 2) {
    SBAR(); qkt(pB0, pB1, K_lds + SHM_K, qr, qrope, kb);
    finishSM(pA0, pA1, alA, l_reg, pa0, pa1, pa2, pa3); SBAR();
    SLOAD(SO, (j + SDEPTH) * KVBLK); SBAR();
    pv_d0(o, vb0, pa0, pa1, pa2, pa3); partialSM(pB0, pB1, m_reg, mnB, alB);
    __syncthreads(); SWAIT(); SWRITE(0, SE);
    RESC(alB); __syncthreads();
    SBAR(); qkt(pA0, pA1, K_lds, qr, qrope, kb);
    finishSM(pB0, pB1, alB, l_reg, pa0, pa1, pa2, pa3); SBAR();
    if (SDEPTH == 1 || j + 3 < NT) SLOAD(SE, (j + 1 + SDEPTH) * KVBLK); SBAR();
    pv_d0(o, vb0 + SHM_V, pa0, pa1, pa2, pa3); partialSM(pA0, pA1, m_reg, mnA, alA);
    __syncthreads(); SWAIT(); SWRITE(1, SO);
    RESC(alA); __syncthreads();
  }
  SBAR(); qkt(pB0, pB1, K_lds + SHM_K, qr, qrope, kb);
  finishSM(pA0, pA1, alA, l_reg, pa0, pa1, pa2, pa3); SBAR();
  pv_d0(o, vb0, pa0, pa1, pa2, pa3); partialSM(pB0, pB1, m_reg, mnB, alB);
  __syncthreads(); RESC(alB);
  finishSM(pB0, pB1, alB, l_reg, pa0, pa1, pa2, pa3); SBAR();
  pv_d0(o, vb0 + SHM_V, pa0, pa1, pa2, pa3);
  if (hi == 0) li_l[r32] = l_reg; asm volatile("s_waitcnt lgkmcnt(0)" ::: "memory");
  __syncthreads();
  {
    constexpr int RS = 272;
    int tid_e = threadIdx.x; asm volatile("" : "+v"(tid_e));
    const int wid = tid_e >> 6, lane = tid_e & 63, r32 = lane & 31, hi = lane >> 5;
    char* Ost = lds + wid * (32 * RS);
#pragma unroll
    for (int r = 0; r < 16; ++r) { const int rw = crow(r, hi); const float rl = __builtin_amdgcn_rcpf(li_l[rw]);
#pragma unroll
      for (int d0 = 0; d0 < 4; ++d0) *(bf16_t*)(Ost + rw * RS + (d0 * 32 + r32) * 2) = f2bf(o[d0][r] * rl); }
    asm volatile("s_waitcnt lgkmcnt(0)" ::: "memory");
#pragma unroll
    for (int i = 0; i < 8; ++i) { const int q = lane + 64 * i, row = q >> 4, cc = q & 15; const long orow = wid * QBLK + row;
      const u32x4 ov = *(const u32x4*)(Ost + row * RS + cc * 16); const u32x4 gv = *(const u32x4*)(gate + orow * NZ + cc * 8);
      u32x4 w; w.x = cvt_pk_bf16(bf_lo(ov.x) * bf_lo(gv.x), bf_hi(ov.x) * bf_hi(gv.x)); w.y = cvt_pk_bf16(bf_lo(ov.y) * bf_lo(gv.y), bf_hi(ov.y) * bf_hi(gv.y));
      w.z = cvt_pk_bf16(bf_lo(ov.z) * bf_lo(gv.z), bf_hi(ov.z) * bf_hi(gv.z)); w.w = cvt_pk_bf16(bf_lo(ov.w) * bf_lo(gv.w), bf_hi(ov.w) * bf_hi(gv.w));
      *(u32x4*)(Yo + orow * 4096 + cc * 8) = w; }
  }
  __syncthreads();
#undef SLOAD
#undef SWRITE
#undef SWAIT
#undef RESC
}

constexpr int DMA_KRING = 0, DMA_VRING = 3 * SHM_K, DMA_WS = 3 * SHM_K + 3 * SHM_V, SHM_ATTN_DMA = DMA_WS + NW * 64 * 4;
__device__ __forceinline__ void qkt12(f32x16& p0, f32x16& p1, const char* Ks, const bf16x8 (&qr)[12], const int (&kb)[4]) {
  p0 = f32x16{}; p1 = f32x16{};
#define KLD(d, half) (*reinterpret_cast<const bf16x8*>(Ks + kb[(d) & 3] + ((d) >> 2) * 128 + (half) * (32 * 384)))
  bf16x8 c0 = KLD(0, 0), c1 = KLD(0, 1);
#pragma unroll
  for (int d0 = 0; d0 < 12; ++d0) {
    bf16x8 n0 = c0, n1 = c1;
    if (d0 < 11) { n0 = KLD(d0 + 1, 0); n1 = KLD(d0 + 1, 1); }
    __builtin_amdgcn_sched_group_barrier(0x100, 2, 0);
    p0 = __builtin_amdgcn_mfma_f32_32x32x16_bf16(c0, qr[d0], p0, 0, 0, 0);
    p1 = __builtin_amdgcn_mfma_f32_32x32x16_bf16(c1, qr[d0], p1, 0, 0, 0);
    __builtin_amdgcn_sched_group_barrier(0x008, 2, 0);
    c0 = n0; c1 = n1; }
#undef KLD
}
__device__ __forceinline__ void attn_unit_dma(const bf16_t* __restrict__ Qb, const bf16_t* __restrict__ Kh, const bf16_t* __restrict__ Vh, int seq, char* lds, LAS unsigned char* ldsl,
                                              const bf16_t* __restrict__ gate, bf16_t* __restrict__ Yo, const float* __restrict__ gq, const float* __restrict__ rope, int tok0) {
  const int tid = tid_fresh(), wid = __builtin_amdgcn_readfirstlane(tid >> 6), lane = tid & 63, r32 = lane & 31, hi = lane >> 5;
  float* li_l = (float*)(lds + DMA_WS) + wid * 64;
  float l_reg = 0; f32x16 o[4] = {}; bf16x8 qr[12];
  const bf16_t* Qw = Qb + (long)(wid * QBLK + r32) * LDQ + hi * 8;
#pragma unroll
  for (int d0 = 0; d0 < 12; ++d0) qr[d0] = *reinterpret_cast<const bf16x8*>(Qw + d0 * 16);
  {
    float ss = 0.f;
#pragma unroll
    for (int d0 = 0; d0 < 12; ++d0) { const u32x4 w = *reinterpret_cast<const u32x4*>(&qr[d0]); float f[8]; f[0] = bf_lo(w.x); f[1] = bf_hi(w.x); f[2] = bf_lo(w.y); f[3] = bf_hi(w.y); f[4] = bf_lo(w.z); f[5] = bf_hi(w.z); f[6] = bf_lo(w.w); f[7] = bf_hi(w.w);
#pragma unroll
      for (int e = 0; e < 8; ++e) ss += f[e] * f[e]; }
    ss += __shfl_xor(ss, 32);
    const float rstd = rsqrtf(ss * (1.0f / DQK) + EPS) * (SCALE * 1.4426950408889634f);
#pragma unroll
    for (int d0 = 0; d0 < 8; ++d0) { const u32x4 w = *reinterpret_cast<const u32x4*>(&qr[d0]); float f[8]; f[0] = bf_lo(w.x); f[1] = bf_hi(w.x); f[2] = bf_lo(w.y); f[3] = bf_hi(w.y); f[4] = bf_lo(w.z); f[5] = bf_hi(w.z); f[6] = bf_lo(w.w); f[7] = bf_hi(w.w);
      const f32x4 g0 = *(const f32x4*)(gq + d0 * 16 + hi * 8), g1 = *(const f32x4*)(gq + d0 * 16 + hi * 8 + 4);
      u32x4 o; o.x = cvt_pk_bf16(f[0] * rstd * g0[0], f[1] * rstd * g0[1]); o.y = cvt_pk_bf16(f[2] * rstd * g0[2], f[3] * rstd * g0[3]); o.z = cvt_pk_bf16(f[4] * rstd * g1[0], f[5] * rstd * g1[1]); o.w = cvt_pk_bf16(f[6] * rstd * g1[2], f[7] * rstd * g1[3]);
      qr[d0] = *reinterpret_cast<const bf16x8*>(&o); }
    const int t = tok0 + wid * QBLK + r32;
#pragma unroll
    for (int ax = 0; ax < 2; ++ax) {
      const int pos = tok0 < 0 ? 0 : (ax == 0 ? (t >> 6) : (t & 63));
      const u32x4 w1 = *reinterpret_cast<const u32x4*>(&qr[8 + 2 * ax]), w2 = *reinterpret_cast<const u32x4*>(&qr[9 + 2 * ax]);
      float x1[8], x2[8]; x1[0] = bf_lo(w1.x); x1[1] = bf_hi(w1.x); x1[2] = bf_lo(w1.y); x1[3] = bf_hi(w1.y); x1[4] = bf_lo(w1.z); x1[5] = bf_hi(w1.z); x1[6] = bf_lo(w1.w); x1[7] = bf_hi(w1.w);
      x2[0] = bf_lo(w2.x); x2[1] = bf_hi(w2.x); x2[2] = bf_lo(w2.y); x2[3] = bf_hi(w2.y); x2[4] = bf_lo(w2.z); x2[5] = bf_hi(w2.z); x2[6] = bf_lo(w2.w); x2[7] = bf_hi(w2.w);
      float o1[8], o2[8];
#pragma unroll
      for (int e = 0; e < 8; ++e) { const f32x2 cs = tok0 < 0 ? (f32x2){1.f, 0.f} : *(const f32x2*)(rope + ((size_t)pos * 16 + hi * 8 + e) * 2);
        const float y1 = x1[e] * rstd * gq[128 + 32 * ax + hi * 8 + e], y2 = x2[e] * rstd * gq[144 + 32 * ax + hi * 8 + e];
        o1[e] = y1 * cs.x - y2 * cs.y; o2[e] = y1 * cs.y + y2 * cs.x; }
      u32x4 a, b; a.x = cvt_pk_bf16(o1[0], o1[1]); a.y = cvt_pk_bf16(o1[2], o1[3]); a.z = cvt_pk_bf16(o1[4], o1[5]); a.w = cvt_pk_bf16(o1[6], o1[7]);
      b.x = cvt_pk_bf16(o2[0], o2[1]); b.y = cvt_pk_bf16(o2[2], o2[3]); b.z = cvt_pk_bf16(o2[4], o2[5]); b.w = cvt_pk_bf16(o2[6], o2[7]);
      qr[8 + 2 * ax] = *reinterpret_cast<const bf16x8*>(&a); qr[9 + 2 * ax] = *reinterpret_cast<const bf16x8*>(&b); }
  }
  int kb[4];
#pragma unroll
  for (int d = 0; d < 4; ++d) kb[d] = r32 * 384 + (((d * 2 + hi) ^ ((r32 >> 1) & 7)) << 4);
  unsigned kdo[3], vdo[2];
#pragma unroll
  for (int i = 0; i < 3; ++i) { const int byte = ((wid * 3 + i) * 64 + lane) * 16, row = byte / 384, off = byte - row * 384; kdo[i] = (unsigned)(row * (LDK * 2) + (off ^ (((row >> 1) & 7) << 4))); }
#pragma unroll
  for (int i = 0; i < 2; ++i) { const int P = (wid * 2 + i) * 64 + lane, sub = P >> 5, within = P & 31, kk = (sub >> 2) * 8 + (within >> 2), k = (kk & ~0xC) | ((kk & 4) << 1) | ((kk & 8) >> 1), c8 = (sub & 3) * 32 + (within & 3) * 8;
    vdo[i] = (unsigned)(k * (LDV * 2) + c8 * 2); }
  const int vb0 = (int)(uintptr_t)(lds + DMA_VRING) + v_rd_base(lane);
#define KDMA(t, slot) do { const char* g_ = (const char*)Kh + (size_t)(t) * (KVBLK * LDK * 2); _Pragma("unroll") for (int i_ = 0; i_ < 3; ++i_) \
    __builtin_amdgcn_global_load_lds((const unsigned*)(g_ + kdo[i_]), (LAS unsigned*)(ldsl + DMA_KRING + (slot) * SHM_K + (wid * 3 + i_) * 1024), 16, 0, 0); } while (0)
#define VDMA(t, slot) do { const char* g_ = (const char*)Vh + (size_t)(t) * (KVBLK * LDV * 2); _Pragma("unroll") for (int i_ = 0; i_ < 2; ++i_) \
    __builtin_amdgcn_global_load_lds((const unsigned*)(g_ + vdo[i_]), (LAS unsigned*)(ldsl + DMA_VRING + (slot) * SHM_V + (wid * 2 + i_) * 1024), 16, 0, 0); } while (0)
#define NEXT3(s) ((s) == 2 ? 0 : (s) + 1)
#define RESC(a) do { if (__any((a) < 1.f)) { _Pragma("unroll") for (int r = 0; r < 16; ++r) { const float ar_ = __shfl((a), crow(r, hi)); \
    _Pragma("unroll") for (int d = 0; d < 4; ++d) o[d][r] *= ar_; } } } while (0)
#define TOP(t, st) do { if ((t) + 2 < NT) asm volatile("s_waitcnt vmcnt(5)" ::: "memory"); else asm volatile("s_waitcnt vmcnt(0)" ::: "memory"); \
    __builtin_amdgcn_s_barrier(); asm volatile("" ::: "memory"); \
    if ((t) + 2 < NT) KDMA((t) + 2, NEXT3(NEXT3(st))); if ((t) + 1 < NT) VDMA((t) + 1, NEXT3(st)); } while (0)
  f32x16 pA0, pA1, pB0, pB1; bf16x8 pa0, pa1, pa2, pa3; const int NT = seq / KVBLK;
  KDMA(0, 0); VDMA(0, 0); KDMA(1, 1);
  int st = 0;
  TOP(0, st);
  qkt12(pA0, pA1, lds + DMA_KRING + st * SHM_K, qr, kb); partialSM_fix(pA0, pA1);
  for (int j = 1; j + 1 < NT; j += 2) {
    int sp = st; st = NEXT3(st);
    TOP(j, st);
    SBAR(); qkt12(pB0, pB1, lds + DMA_KRING + st * SHM_K, qr, kb);
    finishSM_fix(pA0, pA1, l_reg, pa0, pa1, pa2, pa3); SBAR();
    pv_d0(o, vb0 + sp * SHM_V, pa0, pa1, pa2, pa3); partialSM_fix(pB0, pB1);
    sp = st; st = NEXT3(st);
    TOP(j + 1, st);
    SBAR(); qkt12(pA0, pA1, lds + DMA_KRING + st * SHM_K, qr, kb);
    finishSM_fix(pB0, pB1, l_reg, pa0, pa1, pa2, pa3); SBAR();
    pv_d0(o, vb0 + sp * SHM_V, pa0, pa1, pa2, pa3); partialSM_fix(pA0, pA1);
  }
  { int sp = st; st = NEXT3(st);
    TOP(NT - 1, st);
    SBAR(); qkt12(pB0, pB1, lds + DMA_KRING + st * SHM_K, qr, kb);
    finishSM_fix(pA0, pA1, l_reg, pa0, pa1, pa2, pa3); SBAR();
    pv_d0(o, vb0 + sp * SHM_V, pa0, pa1, pa2, pa3); partialSM_fix(pB0, pB1);
    finishSM_fix(pB0, pB1, l_reg, pa0, pa1, pa2, pa3); SBAR();
    pv_d0(o, vb0 + st * SHM_V, pa0, pa1, pa2, pa3); }
  l_reg += __shfl_xor(l_reg, 32);
  if (hi == 0) li_l[r32] = l_reg; asm volatile("s_waitcnt vmcnt(0) lgkmcnt(0)" ::: "memory");
  __syncthreads();
  {
    constexpr int RS = 272;
    int tid_e = threadIdx.x; asm volatile("" : "+v"(tid_e));
    const int wid = tid_e >> 6, lane = tid_e & 63, r32 = lane & 31, hi = lane >> 5;
    char* Ost = lds + wid * (32 * RS);
#pragma unroll
    for (int r = 0; r < 16; ++r) { const int rw = crow(r, hi); const float rl = __builtin_amdgcn_rcpf(li_l[rw]);
#pragma unroll
      for (int d0 = 0; d0 < 4; ++d0) *(bf16_t*)(Ost + rw * RS + (d0 * 32 + r32) * 2) = f2bf(o[d0][r] * rl); }
    asm volatile("s_waitcnt lgkmcnt(0)" ::: "memory");
#pragma unroll
    for (int i = 0; i < 8; ++i) { const int q = lane + 64 * i, row = q >> 4, cc = q & 15; const long orow = wid * QBLK + row;
      const u32x4 ov = *(const u32x4*)(Ost + row * RS + cc * 16); const u32x4 gv = *(const u32x4*)(gate + orow * NZ + cc * 8);
      u32x4 w; w.x = cvt_pk_bf16(bf_lo(ov.x) * bf_lo(gv.x), bf_hi(ov.x) * bf_hi(gv.x)); w.y = cvt_pk_bf16(bf_lo(ov.y) * bf_lo(gv.y), bf_hi(ov.y) * bf_hi(gv.y));
      w.z = cvt_pk_bf16(bf_lo(ov.z) * bf_lo(gv.z), bf_hi(ov.z) * bf_hi(gv.z)); w.w = cvt_pk_bf16(bf_lo(ov.w) * bf_lo(gv.w), bf_hi(ov.w) * bf_hi(gv.w));
      *(u32x4*)(Yo + orow * 4096 + cc * 8) = w; }
  }
  __syncthreads();
#undef KDMA
#undef VDMA
#undef NEXT3
#undef RESC
#undef TOP
}
#undef KSWZ
}

#define XB_TMO      128
#define XB_XCNT(j)  (256  + 64 * (j))
#define XB_XSUB(j)  (1280 + 64 * (j))
#define XB_XGEN(j)  (2304 + 64 * (j))
#define XB_TOP      3328
#define XB_TOPGEN   3392
#define XCD_BAR_WORDS 3456
#define XB_SPIN_CAP (1u << 18)
__device__ __forceinline__ unsigned xb_ld(unsigned* p)              { return __hip_atomic_load(p, __ATOMIC_RELAXED, __HIP_MEMORY_SCOPE_AGENT); }
__device__ __forceinline__ unsigned xb_add(unsigned* p, unsigned v) { return __hip_atomic_fetch_add(p, v, __ATOMIC_RELAXED, __HIP_MEMORY_SCOPE_AGENT); }
__device__ __forceinline__ unsigned xb_xcc_id() { return (unsigned)__builtin_amdgcn_s_getreg((3 << 11) | 20) & 0xFu; }
#define XB_SPIN(cond, bar) do { unsigned _sp = 0; while (cond) { __builtin_amdgcn_s_sleep(1); \
    if ((++_sp & 255u) == 0u) { if (xb_ld(&(bar)[XB_TMO])) break; if (_sp > XB_SPIN_CAP) { atomicAdd(&(bar)[XB_TMO], 1u); break; } } } } while (0)
struct XcdBarrier { unsigned* bar; unsigned x; volatile LAS unsigned* st; };
__device__ __forceinline__ XcdBarrier xcd_barrier_post(unsigned* bar, volatile LAS unsigned* st) {
    XcdBarrier b; b.bar = bar; b.x = xb_xcc_id(); b.st = st;
    if (threadIdx.x == 0) (void)xb_add(&bar[XB_XCNT(b.x)], 1u);
    return b;
}
__device__ __forceinline__ void xcd_barrier_complete(unsigned* bar, unsigned x, unsigned& nloc, unsigned& nx) {
    const unsigned G = gridDim.x * gridDim.y * gridDim.z;
    unsigned sum, cnt, mine, sp = 0u;
    for (;;) {
        sum = 0u; cnt = 0u; mine = 0u;
#pragma unroll
        for (unsigned j = 0; j < 16; ++j) { const unsigned c = xb_ld(&bar[XB_XCNT(j)]); sum += c; cnt += (c > 0u) ? 1u : 0u; mine = (j == x) ? c : mine; }
        if (sum == G) break;
        __builtin_amdgcn_s_sleep(1);
        if ((++sp & 255u) == 0u) { if (xb_ld(&bar[XB_TMO])) break; if (sp > XB_SPIN_CAP) { atomicAdd(&bar[XB_TMO], 1u); break; } }
    }
    nloc = mine > 0u ? mine : 1u; nx = cnt > 0u ? cnt : 1u;
}
__device__ __forceinline__ void xcd_barrier(const XcdBarrier& b) {
    asm volatile("s_waitcnt vmcnt(0)" ::: "memory");
    __syncthreads();
    if (threadIdx.x == 0) {
        unsigned* bar = b.bar; asm volatile("" : "+s"(bar));
        __builtin_amdgcn_s_waitcnt(0);
        unsigned bx_ = b.x; asm volatile("" : "+s"(bx_));
        unsigned nloc = b.st[0], nx = b.st[1];
        if (nloc == 0u) { xcd_barrier_complete(bar, bx_, nloc, nx); b.st[0] = nloc; b.st[1] = nx; }
        const unsigned old = xb_add(&bar[XB_XSUB(bx_)], 1u);
        const unsigned gen = old / nloc;
        if (old + 1u == (gen + 1u) * nloc) {
            __builtin_amdgcn_fence(__ATOMIC_RELEASE, "agent");
            asm volatile("s_waitcnt vmcnt(0)" ::: "memory");
            const unsigned og = xb_add(&bar[XB_TOP], 1u);
            const unsigned tg = og / nx;
            if (og + 1u == (tg + 1u) * nx) xb_add(&bar[XB_TOPGEN], 1u);
            else XB_SPIN(xb_ld(&bar[XB_TOPGEN]) == tg, bar);
            __builtin_amdgcn_fence(__ATOMIC_ACQUIRE, "agent");
            xb_add(&bar[XB_XGEN(bx_)], 1u);
            asm volatile("s_waitcnt vmcnt(0)" ::: "memory");
        } else {
            XB_SPIN(xb_ld(&bar[XB_XGEN(bx_)]) == gen, bar);
            __builtin_amdgcn_fence(__ATOMIC_ACQUIRE, "agent");
            asm volatile("s_waitcnt vmcnt(0)" ::: "memory");
        }
    }
    __syncthreads();
}

struct Args {
    const float* in[24]; float* out; unsigned char* ws; int ph_lo, ph_hi;
};

struct Frame {
    LAS unsigned char* lds; char* ldsg;
    int tid, lane, wave, vcu, G, bx;
    const float* const* in; float* out; unsigned char* ws;
};
template <class T> __device__ __forceinline__ T* wsp(const Frame& F, size_t off) { return (T*)(F.ws + off); }

__device__ __forceinline__ void p0_transpose_item(const float* W, int N, bf16_t* WT, int ldt, int k0, int n0, int nrow0, int kcol0, LAS float* scr, int lane) {
#pragma unroll 8
    for (int i = 0; i < 32; ++i) { const int kk = 2 * i + (lane >> 5); scr[kk * 33 + (lane & 31)] = W[(size_t)(k0 + kk) * N + n0 + (lane & 31)]; }
    LDS_WAIT(); asm volatile("" ::: "memory");
    const int c = lane & 7;
#pragma unroll
    for (int j = 0; j < 4; ++j) { const int n = (lane >> 3) + 8 * j; const LAS float* s = scr + (8 * c) * 33 + n;
        u32x4 o; o.x = cvt_pk_bf16(s[0 * 33], s[1 * 33]); o.y = cvt_pk_bf16(s[2 * 33], s[3 * 33]); o.z = cvt_pk_bf16(s[4 * 33], s[5 * 33]); o.w = cvt_pk_bf16(s[6 * 33], s[7 * 33]);
        *(u32x4*)(WT + (size_t)(nrow0 + n) * ldt + kcol0 + k0 + 8 * c) = o; }
    LDS_WAIT(); asm volatile("" ::: "memory");
}
struct TrJob { int in_idx; int K, N; size_t lw_off; int ldt; int kcol0; };
__device__ __forceinline__ void p0_prologue(const Frame& F) {
    {
        LAS float* sv = (LAS float*)(F.lds);
        LAS float* red = (LAS float*)(F.lds + 4096);
        const float* cvec = F.in[1]; const float* cctx = F.in[3];
        float* MOD = wsp<float>(F, WS_MOD);
        for (int it = F.bx; it < 2 * 32 * 24; it += F.G) {
            const int l = it / 768, r = it % 768, kc = r / 24, nb = r % 24;
            const float* W = F.in[5] + (size_t)l * DM * 12288; const float* bias = F.in[6] + (size_t)l * 12288;
            if (F.tid < 384) { const int j = F.tid >> 7, k = kc * 128 + (F.tid & 127); const float v = j < 2 ? cvec[j * DM + k] : cctx[k]; sv[F.tid] = v * sigmoidf_(v); }
            __syncthreads();
            const int cg = F.tid & 127, rs = F.tid >> 7, n = nb * 512 + cg * 4;
            f32x4 a0 = {0.f, 0.f, 0.f, 0.f}, a1 = a0, a2 = a0;
#pragma unroll 8
            for (int i = 0; i < 32; ++i) { const int kk = rs + 4 * i; const f32x4 w = *(const f32x4*)(W + (size_t)(kc * 128 + kk) * 12288 + n);
                a0 += w * sv[kk]; a1 += w * sv[128 + kk]; a2 += w * sv[256 + kk]; }
            *(LAS f32x4*)(red + (rs * 3 + 0) * 512 + cg * 4) = a0; *(LAS f32x4*)(red + (rs * 3 + 1) * 512 + cg * 4) = a1; *(LAS f32x4*)(red + (rs * 3 + 2) * 512 + cg * 4) = a2;
            __syncthreads();
            for (int e = F.tid; e < 1536; e += NTHR) { const int j = e >> 9, col = e & 511;
                float s = red[(0 * 3 + j) * 512 + col] + red[(1 * 3 + j) * 512 + col] + red[(2 * 3 + j) * 512 + col] + red[(3 * 3 + j) * 512 + col];
                if (kc == 0) s += bias[nb * 512 + col];
                atomicAdd(MOD + ((size_t)l * 3 + j) * 12288 + nb * 512 + col, s); }
            __syncthreads();
        }
    }
    const int gw = F.vcu * NWAVES + F.wave, NGW = F.G * NWAVES;
#pragma unroll 1
    for (int rep0 = 0; rep0 < DUP_P0; ++rep0)
    {
        LAS float* scr = (LAS float*)(F.lds + F.wave * 16384);
        const TrJob jobs[9] = { {7, 4096, NIN, LW_IN, 4096, 0}, {9, 768, 3072, LW_UQ, 768, 0}, {11, 512, 4096, LW_UKV, 512, 0}, {14, 1024, 1024, LW_FN, 1024, 0}, {19, 1024, 1024, LW_PW2, 1024, 0},
                                {20, 1024, 4096, LW_BR, 4096, 0}, {21, 2048, 4096, LW_BR, 4096, 1024}, {22, 1024, 4096, LW_BR, 4096, 3072}, {23, 4096, 4096, LW_OUT, 4096, 0} };
        int base = 0;
#pragma unroll
        for (int l = 0; l < NL; ++l)
#pragma unroll
            for (int jb = 0; jb < 9; ++jb) {
                const TrJob J = jobs[jb]; const int nblk = J.N / 32, nitems = (J.K / 64) * nblk;
                const float* W = F.in[J.in_idx] + (size_t)l * J.K * J.N; bf16_t* WT = (bf16_t*)(F.ws + WS_W + (size_t)l * LAYER_W + J.lw_off);
                int first = (gw - base % NGW + NGW) % NGW;
                for (int it = first; it < nitems; it += NGW) { const int kb = it / nblk, nbk = it % nblk, n0 = nbk * 32;
                    const int nrow0 = (jb == 0 && n0 >= 3392) ? n0 + 192 : n0;
                    p0_transpose_item(W, J.N, WT, J.ldt, kb * 64, n0, nrow0, J.kcol0, scr, F.lane); }
                base += nitems;
            }
    }
    const size_t gt = (size_t)F.vcu * NTHR + F.tid, NGT = (size_t)F.G * NTHR;
    for (int l = 0; l < NL; ++l) { u32x4* p = (u32x4*)(F.ws + WS_W + (size_t)l * LAYER_W + LW_IN + (size_t)3392 * DM * 2);
        for (size_t i = gt; i < (size_t)192 * DM * 2 / 16; i += NGT) p[i] = (u32x4){0u, 0u, 0u, 0u}; }
    {
        bf16_t* TAB = wsp<bf16_t>(F, WS_COS);
        for (size_t i = gt; i < (size_t)2048 * 256; i += NGT) { const int k = (int)(i >> 8), s0 = ((int)i & 255) * 8; float ce[8], se[8], co[8], so[8];
#pragma unroll
            for (int j = 0; j < 8; ++j) { const int pe = (2 * k * (s0 + j)) & 8191, po = ((2 * k + 1) * (s0 + j)) & 8191;
                sincospif((float)pe * (1.0f / 4096.0f), &se[j], &ce[j]); sincospif((float)po * (1.0f / 4096.0f), &so[j], &co[j]); }
            const size_t o = (size_t)k * 2048 + s0;
            *(u32x4*)(TAB + o) = pack8(ce); *(u32x4*)(TAB + (size_t)1 * 2048 * 2048 + o) = pack8(co);
            *(u32x4*)(TAB + (size_t)2 * 2048 * 2048 + o) = pack8(se); *(u32x4*)(TAB + (size_t)3 * 2048 * 2048 + o) = pack8(so); }
        bf16_t* CS = wsp<bf16_t>(F, WS_CS);
        for (size_t i = gt; i < (size_t)1024 * 128; i += NGT) { const int m = (int)(i >> 7), c0 = ((int)i & 127) * 8; float cv[8], sv[8];
#pragma unroll
            for (int j = 0; j < 8; ++j) { const int p = (m * (c0 + j)) & 1023; sincospif((float)p * (1.0f / 512.0f), &sv[j], &cv[j]); }
            u32x4 a, b; a.x = cvt_pk_bf16(cv[0], cv[1]); a.y = cvt_pk_bf16(cv[2], cv[3]); a.z = cvt_pk_bf16(cv[4], cv[5]); a.w = cvt_pk_bf16(cv[6], cv[7]);
            b.x = cvt_pk_bf16(sv[0], sv[1]); b.y = cvt_pk_bf16(sv[2], sv[3]); b.z = cvt_pk_bf16(sv[4], sv[5]); b.w = cvt_pk_bf16(sv[6], sv[7]);
            *(u32x4*)(CS + (size_t)m * 1024 + c0) = a; *(u32x4*)(CS + (size_t)(1024 + m) * 1024 + c0) = b; }
        bf16_t* CS256 = wsp<bf16_t>(F, WS_CS256);
        for (size_t i = gt; i < (size_t)256 * 32; i += NGT) { const int k = (int)(i >> 5), s0 = ((int)i & 31) * 8; float cv[8], sv[8];
#pragma unroll
            for (int j = 0; j < 8; ++j) { const int p = (k * (s0 + j)) & 255; sincospif((float)p * (1.0f / 128.0f), &sv[j], &cv[j]); }
            u32x4 a, b; a.x = cvt_pk_bf16(cv[0], cv[1]); a.y = cvt_pk_bf16(cv[2], cv[3]); a.z = cvt_pk_bf16(cv[4], cv[5]); a.w = cvt_pk_bf16(cv[6], cv[7]);
            b.x = cvt_pk_bf16(-sv[0], -sv[1]); b.y = cvt_pk_bf16(-sv[2], -sv[3]); b.z = cvt_pk_bf16(-sv[4], -sv[5]); b.w = cvt_pk_bf16(-sv[6], -sv[7]);
            *(u32x4*)(CS256 + (size_t)k * 512 + s0) = a; *(u32x4*)(CS256 + (size_t)k * 512 + 256 + s0) = b; }
        float* ROPE = wsp<float>(F, WS_ROPE);
        for (size_t i = gt; i < 128 * 16; i += NGT) { const int pos = (int)i >> 4, f = (int)i & 15; const float inv = powf(10000.0f, -(float)f / 16.0f); const float ang = (float)pos * inv;
            float s, c; sincosf(ang, &s, &c); ROPE[i * 2] = c; ROPE[i * 2 + 1] = s; }
    }
}

__device__ __forceinline__ void phase_norm_mod(const Frame& F, int layer, const float* xl, const float* xc) {
    const int gw = F.vcu * NWAVES + F.wave, NGW = F.G * NWAVES;
    bf16_t* H = wsp<bf16_t>(F, WS_H);
    LAS float* GS = (LAS float*)F.lds; LAS float* SH = (LAS float*)(F.lds + 3 * DM * 4);
    { const float* g = F.in[4] + (size_t)layer * DM; const float* mod = wsp<float>(F, WS_MOD) + (size_t)layer * 3 * 12288;
      for (int i = F.tid; i < 3 * (DM / 4); i += NTHR) { const int j = i / (DM / 4), n = (i - j * (DM / 4)) * 4;
          const f32x4 gv = *(const f32x4*)(g + n), sh = *(const f32x4*)(mod + (size_t)j * 12288 + n), sc = *(const f32x4*)(mod + (size_t)j * 12288 + DM + n);
          *(LAS f32x4*)(GS + j * DM + n) = gv * (sc + 1.0f); *(LAS f32x4*)(SH + j * DM + n) = sh; }
      __syncthreads(); }
    for (int m = gw; m < MROWS; m += NGW) {
        const int b = m / SB, p = m - b * SB; const bool isctx = p < CTX;
        const float* src = isctx ? xc + ((size_t)b * CTX + p) * DM : xl + ((size_t)b * SEQ + (p - CTX)) * DM;
        const int jm = isctx ? 2 : b;
        f32x4 v[16]; float ss = 0.f;
#pragma unroll
        for (int j = 0; j < 16; ++j) v[j] = *(const f32x4*)(src + 4 * (F.lane + 64 * j));
        if (isctx && layer > 0) {
            const float* pj = wsp<float>(F, WS_ECOS) + ((size_t)b * CTX + p) * DM;
#pragma unroll 1
            for (int ch = 0; ch < 8; ++ch)
#pragma unroll
                for (int j = 0; j < 16; ++j) v[j] += *(const f32x4*)(pj + (size_t)ch * 512 * DM + 4 * (F.lane + 64 * j)); }
#pragma unroll
        for (int j = 0; j < 16; ++j) ss += (v[j].x * v[j].x + v[j].y * v[j].y) + (v[j].z * v[j].z + v[j].w * v[j].w);
        const float rstd = rsqrtf(wave_sum(ss) * (1.0f / DM) + EPS);
#pragma unroll
        for (int j = 0; j < 16; ++j) { const int n = 4 * (F.lane + 64 * j);
            const f32x4 gs = *(const LAS f32x4*)(GS + jm * DM + n), sh = *(const LAS f32x4*)(SH + jm * DM + n);
            const f32x4 h = v[j] * rstd * gs + sh;
            u32x2 w; w.x = cvt_pk_bf16(h.x, h.y); w.y = cvt_pk_bf16(h.z, h.w); *(u32x2*)(H + (size_t)m * DM + n) = w; }
    }
    __syncthreads();
}


__device__ __forceinline__ void phase_c1_lora_norm(const Frame& F, int layer) {
    const int gw = F.vcu * NWAVES + F.wave, NGW = F.G * NWAVES;
    const bf16_t* Z = wsp<bf16_t>(F, WS_Z); bf16_t* NCQ = wsp<bf16_t>(F, WS_NCQ); bf16_t* NCKV = wsp<bf16_t>(F, WS_NCKV);
    const float* gq = F.in[8] + (size_t)layer * QLORA; const float* gkv = F.in[10] + (size_t)layer * KVLORA;
    for (int m = gw; m < MROWS; m += NGW) {
        const bf16_t* zr = Z + (size_t)m * NZ;
        float a[8], b2[8], c[8]; const bool has2 = F.lane < 32;
        unpack8(*(const u32x4*)(zr + ZC_Q + F.lane * 8), a);
        if (has2) unpack8(*(const u32x4*)(zr + ZC_Q + 512 + F.lane * 8), b2); else {
#pragma unroll
            for (int j = 0; j < 8; ++j) b2[j] = 0.f; }
        unpack8(*(const u32x4*)(zr + ZC_KV + F.lane * 8), c);
        float sq = 0.f, sk = 0.f;
#pragma unroll
        for (int j = 0; j < 8; ++j) { sq += a[j] * a[j] + b2[j] * b2[j]; sk += c[j] * c[j]; }
        const float rq = rsqrtf(wave_sum(sq) * (1.0f / QLORA) + EPS), rk = rsqrtf(wave_sum(sk) * (1.0f / KVLORA) + EPS);
#pragma unroll
        for (int j = 0; j < 8; ++j) { a[j] *= rq * gq[F.lane * 8 + j]; c[j] *= rk * gkv[F.lane * 8 + j]; }
        *(u32x4*)(NCQ + (size_t)m * QLORA + F.lane * 8) = pack8(a);
        *(u32x4*)(NCKV + (size_t)m * KVLORA + F.lane * 8) = pack8(c);
        if (has2) {
#pragma unroll
            for (int j = 0; j < 8; ++j) b2[j] *= rq * gq[512 + F.lane * 8 + j];
            *(u32x4*)(NCQ + (size_t)m * QLORA + 512 + F.lane * 8) = pack8(b2); }
    }
}
__device__ __forceinline__ void phase_c2_fold(const Frame& F, int layer) {
    const bf16_t* Z = wsp<bf16_t>(F, WS_Z); bf16_t* EO = wsp<bf16_t>(F, WS_EO); float* V2 = wsp<float>(F, WS_V2) + (size_t)layer * 2048;
    LAS float* red = (LAS float*)F.lds;
    for (int it = F.bx; it < 256; it += F.G) {
        const int b = it >> 7, ch = it & 127;
        const bf16_t* U = Z + ((size_t)b * SB + CTX) * NZ + ZC_F;
        float v2a[16];
#pragma unroll
        for (int j = 0; j < 16; ++j) v2a[j] = 0.f;
#pragma unroll 1
        for (int i = 0; i < 2; ++i) {
            const int s = ch * 16 + F.wave + 8 * i; const float sg = (s & 1) ? -1.f : 1.f;
#pragma unroll
            for (int hh = 0; hh < 2; ++hh) {
                asm volatile("" ::: "memory");
                const int col = (F.lane + 64 * hh) * 8;
                float x[8], y[8], p[8], q[8], ep[8], em[8], om[8], op[8];
                if (s == 0) { unpack8(*(const u32x4*)(U + col), x); unpack8(*(const u32x4*)(U + (size_t)4096 * NZ + col), y); unpack8(*(const u32x4*)(U + (size_t)2048 * NZ + col), p); unpack8(*(const u32x4*)(U + (size_t)6144 * NZ + col), q);
#pragma unroll
                    for (int j = 0; j < 8; ++j) { ep[j] = x[j]; em[j] = x[j]; om[j] = 0.f; op[j] = 0.f; v2a[hh * 8 + j] += (x[j] + y[j]) + (p[j] + q[j]); } }
                else { unpack8(*(const u32x4*)(U + (size_t)s * NZ + col), x); unpack8(*(const u32x4*)(U + (size_t)(SEQ - s) * NZ + col), y);
                    unpack8(*(const u32x4*)(U + (size_t)(4096 - s) * NZ + col), p); unpack8(*(const u32x4*)(U + (size_t)(4096 + s) * NZ + col), q);
#pragma unroll
                    for (int j = 0; j < 8; ++j) { const float es = x[j] + y[j], emr = p[j] + q[j], os = x[j] - y[j], omr = p[j] - q[j];
                        ep[j] = es + emr; em[j] = es - emr; om[j] = os - omr; op[j] = os + omr; v2a[hh * 8 + j] += sg * ep[j]; } }
                bf16_t* dst = EO + ((size_t)(b * 4) * 2048 + s) * 1024 + col;
                *(u32x4*)(dst) = pack8(ep); *(u32x4*)(dst + (size_t)2048 * 1024) = pack8(em); *(u32x4*)(dst + (size_t)2 * 2048 * 1024) = pack8(om); *(u32x4*)(dst + (size_t)3 * 2048 * 1024) = pack8(op);
            }
        }
#pragma unroll
        for (int hh = 0; hh < 2; ++hh)
#pragma unroll
            for (int j = 0; j < 8; ++j) red[F.wave * 1024 + (F.lane + 64 * hh) * 8 + j] = v2a[hh * 8 + j];
        __syncthreads();
        for (int c = F.tid; c < 1024; c += NTHR) { float sm = 0.f;
#pragma unroll
            for (int w = 0; w < 8; ++w) sm += red[w * 1024 + c];
            atomicAdd(V2 + b * 1024 + c, sm); }
        __syncthreads();
    }
}
__device__ __forceinline__ void phase_c3_conv(const Frame& F, int layer, bool with_ctx) {
    const bf16_t* Z = wsp<bf16_t>(F, WS_Z); bf16_t* CU = wsp<bf16_t>(F, WS_CU);
    const float* cw = F.in[15] + (size_t)layer * CONVW * CD; const float* cb = F.in[16] + (size_t)layer * CD;
    const float* lg = F.in[17] + (size_t)layer * CD; const float* lb = F.in[18] + (size_t)layer * CD;
    LAS float* red = (LAS float*)F.lds;
    const int c0 = F.tid * 2;
    float w0[CONVW], w1[CONVW];
#pragma unroll
    for (int j = 0; j < CONVW; ++j) { const f32x2 w = *(const f32x2*)(cw + (size_t)j * CD + c0); w0[j] = w.x; w1[j] = w.y; }
    const f32x2 bias = *(const f32x2*)(cb + c0), gam = *(const f32x2*)(lg + c0), bet = *(const f32x2*)(lb + c0);
    for (int un = F.bx; un < MROWS / 32; un += F.G) {
        const int m0 = un * 32, b = m0 / SB, p0 = m0 - b * SB; const bool isctx = p0 < CTX;
        if (isctx && !with_ctx) continue;
        const int seq_lo = b * SB + (isctx ? 0 : CTX), seq_hi = b * SB + (isctx ? CTX : SB);
        float a0[32], a1[32];
#pragma unroll
        for (int t = 0; t < 32; ++t) { a0[t] = bias.x; a1[t] = bias.y; }
#pragma unroll
        for (int i = 0; i < 62; ++i) {
            const int row = m0 - 15 + i; float u0 = 0.f, u1 = 0.f;
            if (row >= seq_lo && row < seq_hi) { const unsigned wa = *(const unsigned*)(Z + (size_t)row * NZ + ZC_GA + c0), wg = *(const unsigned*)(Z + (size_t)row * NZ + ZC_GG + c0);
                u0 = bf_lo(wa) * bf_lo(wg); u1 = bf_hi(wa) * bf_hi(wg); }
#pragma unroll
            for (int t = 0; t < 32; ++t) { const int j = i - t; if (j >= 0 && j < CONVW) { a0[t] = fmaf(w0[j], u0, a0[t]); a1[t] = fmaf(w1[j], u1, a1[t]); } }
        }
#pragma unroll
        for (int t = 0; t < 32; ++t) { const float s = wave_sum(a0[t] + a1[t]); if (F.lane == 0) red[t * 8 + F.wave] = s; }
        __syncthreads();
        if (F.tid < 32) { float s = 0.f;
#pragma unroll
            for (int w = 0; w < 8; ++w) s += red[F.tid * 8 + w];
            red[1024 + F.tid] = s * (1.0f / CD); }
        __syncthreads();
#pragma unroll
        for (int t = 0; t < 32; ++t) { const float mu = red[1024 + t]; a0[t] -= mu; a1[t] -= mu; }
        __syncthreads();
#pragma unroll
        for (int t = 0; t < 32; ++t) { const float s = wave_sum(a0[t] * a0[t] + a1[t] * a1[t]); if (F.lane == 0) red[t * 8 + F.wave] = s; }
        __syncthreads();
        if (F.tid < 32) { float s = 0.f;
#pragma unroll
            for (int w = 0; w < 8; ++w) s += red[F.tid * 8 + w];
            red[1024 + F.tid] = rsqrtf(s * (1.0f / CD) + EPS); }
        __syncthreads();
#pragma unroll
        for (int t = 0; t < 32; ++t) { const float rs = red[1024 + t];
            float y0 = a0[t] * rs * gam.x + bet.x, y1 = a1[t] * rs * gam.y + bet.y;
            y0 *= sigmoidf_(y0); y1 *= sigmoidf_(y1);
            *(unsigned*)(CU + (size_t)(m0 + t) * CD + c0) = cvt_pk_bf16(y0, y1); }
        __syncthreads();
    }
}
__device__ __forceinline__ void phase_d_specials(const Frame& F, int layer) {
    const bf16_t* Z = wsp<bf16_t>(F, WS_Z); const float* V2 = wsp<float>(F, WS_V2) + (size_t)layer * 2048; float* SPEC = wsp<float>(F, WS_SPEC);
    const bf16_t* CSW = wsp<bf16_t>(F, WS_ZF) + (size_t)layer * 2048 * 1024;
    for (int blk = F.bx; blk < 512; blk += F.G) {
        const int o = blk * 16 + (F.tid >> 5), tl = F.tid & 31;
        const int b = o >> 12, which = (o >> 10) & 3, n = o & 1023;
        const bf16_t* U = Z + ((size_t)b * SB + CTX) * NZ + ZC_F; const bf16_t* T = CSW + (size_t)((which == 3 ? 1024 : 0) + n) * 1024 + tl * 32;
        float sm = 0.f;
#pragma unroll
        for (int q = 0; q < 4; ++q) { float t[8], v[8]; unpack8(*(const u32x4*)(T + q * 8), t); const int c = tl * 32 + q * 8;
            if (which == 0) unpack8(*(const u32x4*)(U + (size_t)4096 * NZ + c), v);
            else if (which == 1) {
#pragma unroll
                for (int j = 0; j < 8; ++j) v[j] = V2[b * 1024 + c + j]; }
            else { float p[8], r[8]; unpack8(*(const u32x4*)(U + (size_t)2048 * NZ + c), p); unpack8(*(const u32x4*)(U + (size_t)6144 * NZ + c), r);
#pragma unroll
                for (int j = 0; j < 8; ++j) v[j] = which == 2 ? p[j] + r[j] : p[j] - r[j]; }
#pragma unroll
            for (int j = 0; j < 8; ++j) sm = fmaf(t[j], v[j], sm); }
#pragma unroll
        for (int off = 1; off < 32; off <<= 1) sm += __shfl_xor(sm, off);
        if (tl == 0) SPEC[o] = sm;
    }
}
__device__ __forceinline__ void phase_e_finalize(const Frame& F, int layer, bool q_ctx, bool q_too) {
    const int gw = F.vcu * NWAVES + F.wave, NGW = F.G * NWAVES;
    bf16_t* QR = wsp<bf16_t>(F, WS_QR); const bf16_t* KVR = wsp<bf16_t>(F, WS_KVR); bf16_t* KN = wsp<bf16_t>(F, WS_KN); const bf16_t* Z = wsp<bf16_t>(F, WS_Z);
    const float* ROPE = wsp<float>(F, WS_ROPE);
    const float* gq = F.in[12] + (size_t)layer * DQK; const float* gk = F.in[13] + (size_t)layer * DQK;
    const int h = F.lane >> 2, j4 = F.lane & 3;
    const int c1 = (j4 & 1) + 4 * (j4 >> 1), c2 = c1 + 2;
    for (int m = gw; m < MROWS; m += NGW) {
        const int b = m / SB, p = m - b * SB; const bool isctx = p < CTX; const int t = p - CTX;
        const int pos = (j4 < 2) ? (t >> 6) : (t & 63);
        float cs[8], sn[8];
        if (!isctx) {
#pragma unroll
            for (int i = 0; i < 8; ++i) { const f32x2 r = *(const f32x2*)(ROPE + ((size_t)pos * 16 + (j4 & 1) * 8 + i) * 2); cs[i] = r.x; sn[i] = r.y; } }
        else {
#pragma unroll
            for (int i = 0; i < 8; ++i) { cs[i] = 1.f; sn[i] = 0.f; } }
#pragma unroll
        for (int qk = 0; qk < 2; ++qk) {
            if (qk == 0 && (!q_too || (isctx && !q_ctx))) continue;
            const float* gn = qk == 0 ? gq : gk;
            float x[4][8], r1[8], r2[8];
            if (qk == 0) { const bf16_t* src = QR + (size_t)m * 3072 + h * DQK;
#pragma unroll
                for (int cc = 0; cc < 4; ++cc) unpack8(*(const u32x4*)(src + (4 * j4 + cc) * 8), x[cc]);
                unpack8(*(const u32x4*)(src + DNOPE + c1 * 8), r1); unpack8(*(const u32x4*)(src + DNOPE + c2 * 8), r2); }
            else { const bf16_t* src = KVR + (size_t)m * 4096 + h * 256; const bf16_t* rs = Z + (size_t)m * NZ + ZC_KR;
#pragma unroll
                for (int cc = 0; cc < 4; ++cc) unpack8(*(const u32x4*)(src + (4 * j4 + cc) * 8), x[cc]);
                unpack8(*(const u32x4*)(rs + c1 * 8), r1); unpack8(*(const u32x4*)(rs + c2 * 8), r2); }
            float ss = 0.f;
#pragma unroll
            for (int cc = 0; cc < 4; ++cc)
#pragma unroll
                for (int i = 0; i < 8; ++i) ss += x[cc][i] * x[cc][i];
#pragma unroll
            for (int i = 0; i < 8; ++i) ss += r1[i] * r1[i] + r2[i] * r2[i];
            ss += __shfl_xor(ss, 1); ss += __shfl_xor(ss, 2);
            const float rstd = rsqrtf(ss * (1.0f / DQK) + EPS);
            bf16_t* dst = (qk == 0 ? QR : KN) + (size_t)m * 3072 + h * DQK;
#pragma unroll
            for (int cc = 0; cc < 4; ++cc) {
#pragma unroll
                for (int i = 0; i < 8; ++i) x[cc][i] *= rstd * gn[(4 * j4 + cc) * 8 + i];
                *(u32x4*)(dst + (4 * j4 + cc) * 8) = pack8(x[cc]); }
            float o1[8], o2[8];
#pragma unroll
            for (int i = 0; i < 8; ++i) { const float y1 = r1[i] * rstd * gn[DNOPE + c1 * 8 + i], y2 = r2[i] * rstd * gn[DNOPE + c2 * 8 + i];
                o1[i] = y1 * cs[i] - y2 * sn[i]; o2[i] = y1 * sn[i] + y2 * cs[i]; }
            *(u32x4*)(dst + DNOPE + c1 * 8) = pack8(o1); *(u32x4*)(dst + DNOPE + c2 * 8) = pack8(o2);
        }
    }
}
__device__ __forceinline__ void phase_g_combine(const Frame& F) {
    const size_t gt = (size_t)F.vcu * NTHR + F.tid, NGT = (size_t)F.G * NTHR;
    const float* G12 = wsp<float>(F, WS_G12); const float* SPEC = wsp<float>(F, WS_SPEC); bf16_t* Y = wsp<bf16_t>(F, WS_Y); const bf16_t* Z = wsp<bf16_t>(F, WS_Z);
    const float sc = 0.00034526698300124393f;
    for (size_t i = gt; i < (size_t)2 * 2048 * 128; i += NGT) {
        const int b = (int)(i >> 18), kp = (int)(i >> 7) & 2047, m0 = ((int)i & 127) * 8; const float sg = (kp & 1) ? -1.f : 1.f;
        const float* g = G12 + ((size_t)(b * 4) * 2048 + kp) * 1024 + m0; const size_t js = (size_t)2048 * 1024;
        const float* sp = SPEC + (size_t)(b * 4) * 1024 + m0;
        float e0[8], e1[8], o0[8], o1[8];
#pragma unroll
        for (int hh = 0; hh < 2; ++hh) { const f32x4 g1e = *(const f32x4*)(g + 4 * hh), g1o = *(const f32x4*)(g + js + 4 * hh), g2e = *(const f32x4*)(g + 2 * js + 4 * hh), g2o = *(const f32x4*)(g + 3 * js + 4 * hh);
            const f32x4 E4 = *(const f32x4*)(sp + 4 * hh), E2 = *(const f32x4*)(sp + 2048 + 4 * hh), O2 = *(const f32x4*)(sp + 3072 + 4 * hh);
#pragma unroll
            for (int j = 0; j < 4; ++j) { const float a1 = g1e[j] + sg * E2[j] + E4[j], a2 = g2e[j]; e0[hh * 4 + j] = (a1 - a2) * sc; e1[hh * 4 + j] = (a1 + a2) * sc;
                const float b1 = g1o[j] - E4[j], b2v = g2o[j] + sg * O2[j]; o0[hh * 4 + j] = (b1 - b2v) * sc; o1[hh * 4 + j] = (b1 + b2v) * sc; } }
        const size_t row0 = (size_t)b * SB + CTX; const int k = 2 * kp;
#define YF_STORE(krow, arr) do { const size_t r_ = row0 + (size_t)(krow); float g_[8], o_[8]; unpack8(*(const u32x4*)(Z + r_ * NZ + ZC_FG + m0), g_); \
            _Pragma("unroll") for (int j = 0; j < 8; ++j) o_[j] = (arr)[j] * g_[j]; *(u32x4*)(Y + r_ * 4096 + m0) = pack8(o_); } while (0)
        YF_STORE(k, e0); YF_STORE(k + 1, o0); YF_STORE(SEQ - k - 1, o1);
        if (kp >= 1) YF_STORE(SEQ - k, e1);
        else { const float* zp = SPEC + (size_t)(b * 4 + 1) * 1024 + m0; float z[8];
#pragma unroll
            for (int j = 0; j < 8; ++j) z[j] = zp[j] * sc;
            YF_STORE(4096, z); }
#undef YF_STORE
    }
}

__device__ __forceinline__ bool att_needs_fallback(const float* gq, const float* gk, int lane) {
    float a = fmaxf(fmaxf(fabsf(gq[lane]), fabsf(gq[64 + lane])), fabsf(gq[128 + lane])), b2 = fmaxf(fmaxf(fabsf(gk[lane]), fabsf(gk[64 + lane])), fabsf(gk[128 + lane]));
#pragma unroll
    for (int o_ = 1; o_ < 64; o_ <<= 1) { a = fmaxf(a, __shfl_xor(a, o_)); b2 = fmaxf(b2, __shfl_xor(b2, o_)); }
    const float bound = (192.0f * a * b2) * (att::SCALE * 1.4426950408889634f);
    return !(bound <= 100.0f);
}
constexpr int NPH = 1 + 10 * NL;
__global__ void __launch_bounds__(NTHR, 2) fwd_kernel(Args args) {
    extern __shared__ __attribute__((aligned(16))) unsigned char lds_raw[];
    Frame F;
    F.lds = (LAS unsigned char*)lds_raw; F.ldsg = (char*)lds_raw;
    F.tid = threadIdx.x; F.lane = F.tid & 63; F.wave = __builtin_amdgcn_readfirstlane(F.tid >> 6);
    F.G = gridDim.x; F.bx = blockIdx.x; F.vcu = (F.G % 8 == 0) ? (F.bx % 8) * (F.G / 8) + F.bx / 8 : F.bx;
    F.in = args.in; F.out = args.out; F.ws = args.ws;
    volatile LAS unsigned* MISC = (volatile LAS unsigned*)(F.lds + MISC_OFF);
    for (int u = F.tid; u < (LDS_BYTES - LDSCTL_OFF) / 4; u += NTHR) ((LAS unsigned*)(F.lds + LDSCTL_OFF))[u] = 0u;
    __syncthreads();
    unsigned* barw = (unsigned*)(F.ws + WS_CTL) + CW_BAR;
    XcdBarrier bar; bar.bar = barw; bar.x = 0; bar.st = nullptr;
#if !MK_PER_PHASE
    bar = xcd_barrier_post(barw, MISC + 8);
#define GRID_BAR() xcd_barrier(bar)
#else
    (void)MISC;
#define GRID_BAR() do { } while (0)
#endif
    const int lo = args.ph_lo, hi = args.ph_hi;
#define IN(k) (lo <= (k) && (k) < hi)
#define REFRESH() do { F.tid = tid_fresh(); F.lane = F.tid & 63; F.wave = __builtin_amdgcn_readfirstlane(F.tid >> 6); { unsigned char* w_ = F.ws; asm volatile("" : "+s"(w_)); F.ws = w_; } \
    { int g_ = F.G, b_ = F.bx, v_ = F.vcu; asm volatile("" : "+s"(g_), "+s"(b_), "+s"(v_)); F.G = g_; F.bx = b_; F.vcu = v_; G = g_; bx = b_; wsb = (const char*)F.ws; } } while (0)
#ifdef ONLY_J
#define INJ(j) ((j) == ONLY_J && IN(P + (j)))
#define IN0 (ONLY_J == -1 && IN(0))
#else
#define INJ(j) IN(P + (j))
#define IN0 IN(0)
#endif
#define SEAM(k) do { if (IN(k) && IN((k) + 1)) GRID_BAR(); } while (0)
    int G = F.G, bx = F.bx;
    const char* wsb = (const char*)F.ws;

    if (IN0) { REFRESH(); p0_prologue(F); } SEAM(0);

#pragma unroll 1
    for (int l = 0; l < NL; ++l) {
        const int P = 1 + 10 * l; const bool full = (l == 0);
        const unsigned char* LW = F.ws + WS_W + (size_t)l * LAYER_W;
        const float* MODL = wsp<float>(F, WS_MOD) + (size_t)l * 3 * 12288;
        if (INJ(0)) { for (int rep = 0; rep < DUP_EW; ++rep) { if (rep) GRID_BAR(); REFRESH(); phase_norm_mod(F, l, l == 0 ? F.in[0] : F.out, F.in[2]); } } SEAM(P + 0);
        if (INJ(1)) {
#pragma unroll 1
          for (int rep = 0; rep < DUP_B; ++rep) {
            if (rep) GRID_BAR();
            REFRESH();
            pg8::EpiZ E{wsp<bf16_t>(F, WS_Z)};
            { pg8::TileSched S; S.init(wsb + WS_H, DM, LW + LW_IN, DM, DM, full ? 0 : 1, 82, 0, G, bx); pg8::gemm_phase(F.lds, S, E, DM, DM); }
            {
              pg8::EpiBf16 Ec{wsp<bf16_t>(F, WS_ZF) + (size_t)l * 2048 * 1024, 1024, 1.0f}; pg8::CswSched Sc{(const char*)(LW + LW_FN), wsb + WS_CS, G, (bx + G - (full ? 40 : 136) % G) % G}; pg8::gemm_phase(F.lds, Sc, Ec, 1024, 1024); }
            if (!full) {
                pg8::TileSched S2; S2.init(wsb + WS_H, DM, LW + LW_IN + (size_t)ZC_KV * DM * 2, DM, DM, 2, 3, ZC_KV, G, (bx + G - (64 * 82) % G) % G); pg8::gemm_phase(F.lds, S2, E, DM, DM); }
          }
        } SEAM(P + 1);
        if (INJ(2)) { for (int rep = 0; rep < DUP_EW; ++rep) { if (rep) GRID_BAR(); REFRESH(); phase_c1_lora_norm(F, l); if (!rep) { REFRESH(); phase_c2_fold(F, l); } REFRESH(); phase_c3_conv(F, l, full); } } SEAM(P + 2);
        if (INJ(3)) {
#pragma unroll 1
          for (int rep = 0; rep < DUP_GS; ++rep) {
            if (rep) GRID_BAR();
            REFRESH(); phase_d_specials(F, l);
            int rot = 0;
            { pg8::EpiBf16 E{wsp<bf16_t>(F, WS_KVR), 4096, 1.0f}; pg8::TileSched S; S.init(wsb + WS_NCKV, KVLORA, LW + LW_UKV, KVLORA, KVLORA, 0, 16, 0, G, bx); pg8::gemm_phase(F.lds, S, E, KVLORA, KVLORA); rot += S.units(); }
            { pg8::EpiBf16 E{wsp<bf16_t>(F, WS_QR), 3072, 1.0f}; pg8::TileSched S; S.init(wsb + WS_NCQ, QLORA, LW + LW_UQ, QLORA, QLORA, full ? 0 : 1, 12, 0, G, (bx + G - rot % G) % G); pg8::gemm_phase(F.lds, S, E, QLORA, QLORA); rot += S.units(); }
            { pg8::EpiGate E{wsp<bf16_t>(F, WS_Y), wsp<bf16_t>(F, WS_Z), 3072, ZC_CG, 1.0f}; pg8::TileSched S; S.init(wsb + WS_CU, CD, LW + LW_PW2, CD, CD, full ? 0 : 1, 4, 0, G, (bx + G - rot % G) % G); pg8::gemm_phase(F.lds, S, E, CD, CD); rot += S.units(); }
            const char* CSWl = wsb + WS_ZF + (size_t)l * 2048 * 1024 * 2;
            { pg8::EpiBf16 E{wsp<bf16_t>(F, WS_ECOS), 16384, 1.0f}; pg8::FchanSched S{CSWl, wsb + WS_EO, G, (bx + G - rot % G) % G}; pg8::gemm_phase(F.lds, S, E, 1024, 1024); rot += 256; }
            if (full) { pg8::EpiBf16 E{wsp<bf16_t>(F, WS_TCT), 512, 1.0f}; pg8::FchanCtxSched S{CSWl, wsb + WS_Z, G, (bx + G - rot % G) % G}; pg8::gemm_phase(F.lds, S, E, 1024, NZ); }
          }
        } SEAM(P + 3);
        if (INJ(4)) { REFRESH(); const bool fb = att_needs_fallback(F.in[12] + (size_t)l * DQK, F.in[13] + (size_t)l * DQK, F.lane); phase_e_finalize(F, l, full, fb); } SEAM(P + 4);
        if (INJ(5)) {
#pragma unroll 1
          for (int rep = 0; rep < DUP_F; ++rep) {
            if (rep) GRID_BAR();
            REFRESH();
            const bf16_t* QR = wsp<bf16_t>(F, WS_QR); const bf16_t* KN = wsp<bf16_t>(F, WS_KN); const bf16_t* KVR = wsp<bf16_t>(F, WS_KVR); const bf16_t* Z = wsp<bf16_t>(F, WS_Z); bf16_t* Y = wsp<bf16_t>(F, WS_Y);
            const int nun = 1024 + (full ? 32 : 0); const bool fb = att_needs_fallback(F.in[12] + (size_t)l * DQK, F.in[13] + (size_t)l * DQK, F.tid & 63);
#define ATT_UNIT_DECODE() \
                const int L = i * G + bx; if (L >= nun) break; \
                int bh, qb = 0, seq; size_t qrow; \
                if (L < 1024) { const int rnd = L / 256, w = L % 256; bh = rnd * 8 + (w & 7); qb = w >> 3; seq = SB; qrow = (size_t)(bh >> 4) * SB + CTX + (size_t)qb * 256; } \
                else { bh = L - 1024; seq = CTX; qrow = (size_t)(bh >> 4) * SB; } \
                const int b = bh >> 4, h = bh & 15; const size_t krow = (size_t)b * SB;
            if (__builtin_expect(!fb, 1)) {
                for (int i = 0;; ++i) { ATT_UNIT_DECODE()
                    att::attn_unit_dma(QR + qrow * 3072 + h * DQK, KN + krow * 3072 + h * DQK, KVR + krow * 4096 + h * 256 + 128, seq, F.ldsg, F.lds,
                               Z + qrow * NZ + ZC_MG + h * 128, Y + qrow * 4096 + 1024 + h * 128, F.in[12] + (size_t)l * DQK, wsp<float>(F, WS_ROPE), L < 1024 ? qb * 256 : -1); }
            } else {
                for (int i = 0;; ++i) { ATT_UNIT_DECODE()
                    att::attn_unit(QR + qrow * 3072 + h * DQK, KN + krow * 3072 + h * DQK, KVR + krow * 4096 + h * 256 + 128, seq, F.ldsg,
                               Z + qrow * NZ + ZC_MG + h * 128, Y + qrow * 4096 + 1024 + h * 128); }
            }
#undef ATT_UNIT_DECODE
            __syncthreads();
#ifndef NO_F2
            { pg8::EpiF32 E{wsp<float>(F, WS_G12), 1024}; pg8::FseqSched S{wsb, G, bx}; pg8::gemm_phase(F.lds, S, E, 2048, 16384); }
            if (full) { pg8::EpiGate E{wsp<bf16_t>(F, WS_Y), wsp<bf16_t>(F, WS_Z), 0, ZC_FG, 0.001953125f}; pg8::FseqCtxSched S{wsb + WS_CS256, wsb + WS_TCT, G, (bx + G - 32) % G}; pg8::gemm_phase(F.lds, S, E, 512, 512); }
#endif
          }
        } SEAM(P + 5);
        if (INJ(6)) { for (int rep = 0; rep < DUP_EW; ++rep) { if (rep) GRID_BAR(); REFRESH(); phase_g_combine(F); } } SEAM(P + 6);
        if (INJ(8)) { for (int rep = 0; rep < DUP_GS; ++rep) { if (rep) GRID_BAR(); REFRESH(); pg8::EpiMerge E{wsp<bf16_t>(F, WS_MRG), wsp<bf16_t>(F, WS_Z)}; pg8::MergeSched S{wsb + WS_Y, (const char*)(LW + LW_BR), 1, 64, G, bx}; pg8::gemm_phase(F.lds, S, E, 4096, 4096); }
            if (full) {
                pg8::EpiMergePart E{wsp<float>(F, WS_G12), wsp<bf16_t>(F, WS_Z)}; pg8::CtxSplitSched S{wsb + WS_Y, (const char*)(LW + LW_BR), 1, G, bx}; pg8::gemm_phase(F.lds, S, E, 4096, 4096); }
        } SEAM(P + 8);
        if (INJ(9)) {
            REFRESH();
            if (full) {
                REFRESH();
                const size_t gt = (size_t)F.vcu * NTHR + F.tid, NGT = (size_t)F.G * NTHR; const float* PI = wsp<float>(F, WS_G12); bf16_t* MR = wsp<bf16_t>(F, WS_MRG);
                for (size_t i = gt; i < (size_t)512 * 512; i += NGT) { const int r = (int)(i >> 9), c8 = ((int)i & 511) * 8; float a[8];
#pragma unroll
                    for (int j = 0; j < 8; ++j) a[j] = 0.f;
#pragma unroll 1
                    for (int ch = 0; ch < 8; ++ch) { const f32x4 x0 = *(const f32x4*)(PI + ((size_t)ch * 512 + r) * 4096 + c8), x1 = *(const f32x4*)(PI + ((size_t)ch * 512 + r) * 4096 + c8 + 4);
                        a[0] += x0[0]; a[1] += x0[1]; a[2] += x0[2]; a[3] += x0[3]; a[4] += x1[0]; a[5] += x1[1]; a[6] += x1[2]; a[7] += x1[3]; }
                    const size_t m = (size_t)(r >> 8) * SB + (r & 255);
                    *(u32x4*)(MR + m * 4096 + c8) = pack8(a); }
                GRID_BAR();
            }
            pg8::EpiOut E{l == 0 ? F.in[0] : F.out, F.in[2], F.out, wsp<float>(F, WS_XC1), MODL};
            pg8::TileSched S; S.init(wsb + WS_MRG, DM, LW + LW_OUT, DM, DM, 1, 16, 0, G, bx); pg8::gemm_phase(F.lds, S, E, DM, DM);
            if (full) { pg8::EpiOutPart E2{wsp<float>(F, WS_ECOS), MODL}; pg8::CtxSplitSched S2{wsb + WS_MRG, (const char*)(LW + LW_OUT), 0, G, bx}; pg8::gemm_phase(F.lds, S2, E2, 4096, 4096); }
        } SEAM(P + 9);
    }
#undef IN
#undef SEAM
#undef GRID_BAR
}

extern "C" void kernel_launch(void* const* d_in, const int* in_sizes, int n_in, void* d_out, int out_size, void* d_ws, size_t ws_size, hipStream_t stream) {
    static int grid = 0;
    if (grid == 0) {
        if (n_in != 24 || out_size != NB * SEQ * DM || ws_size < WS_END) { fprintf(stderr, "kernel_launch: unexpected shapes: n_in %d out %d ws %zu (need %zu)\n", n_in, out_size, ws_size, (size_t)WS_END); grid = -1; return; }
        int dev = 0, cus = 0, per_cu = 0;
        if (hipGetDevice(&dev) != hipSuccess || hipDeviceGetAttribute(&cus, hipDeviceAttributeMultiprocessorCount, dev) != hipSuccess) { grid = -1; return; }
        if (hipFuncSetAttribute((const void*)fwd_kernel, hipFuncAttributeMaxDynamicSharedMemorySize, LDS_BYTES) != hipSuccess) { fprintf(stderr, "kernel_launch: hipFuncSetAttribute failed\n"); grid = -1; return; }
        if (hipOccupancyMaxActiveBlocksPerMultiprocessor(&per_cu, (const void*)fwd_kernel, NTHR, LDS_BYTES) != hipSuccess || per_cu < 1) fprintf(stderr, "kernel_launch: occupancy query says %d\n", per_cu);
        (void)hipGetLastError();
        grid = cus;
    }
    if (grid < 0) return;
    (void)hipMemsetAsync((char*)d_ws + WS_CTL, 0, ZERO_BYTES, stream);
    Args a{};
    for (int i = 0; i < 24; ++i) a.in[i] = (const float*)d_in[i];
    a.out = (float*)d_out; a.ws = (unsigned char*)d_ws;
#if MK_PER_PHASE
    for (int p = 0; p < NPH; ++p) { a.ph_lo = p; a.ph_hi = p + 1; hipLaunchKernelGGL(fwd_kernel, dim3(grid), dim3(NTHR), LDS_BYTES, stream, a); }
#else
    a.ph_lo = 0; a.ph_hi = NPH; hipLaunchKernelGGL(fwd_kernel, dim3(grid), dim3(NTHR), LDS_BYTES, stream, a);
#endif
    const hipError_t le = hipPeekAtLastError();
    if (le != hipSuccess) fprintf(stderr, "kernel_launch: launch failed: %s\n", hipGetErrorName(le));
}
```

```cpp
#include <hip/hip_runtime.h>
#include <cstdio>
#include <cstdint>

#ifndef MK_PER_PHASE
#define MK_PER_PHASE 0
#endif

#define DUP_P0 1
#define DUP_B 1
#define DUP_F 1
#define DUP_EW 1
#define DUP_GS 1
#define ATT_DMA 1

#define LAS __attribute__((address_space(3)))
#define GAS __attribute__((address_space(1)))
typedef unsigned short bf16_t;
typedef short bf16x8 __attribute__((ext_vector_type(8)));
typedef short s16x4 __attribute__((ext_vector_type(4)));
typedef float f32x4 __attribute__((ext_vector_type(4)));
typedef float f32x2 __attribute__((ext_vector_type(2)));
typedef float f32x16 __attribute__((ext_vector_type(16)));
typedef unsigned u32x4 __attribute__((ext_vector_type(4)));
typedef unsigned u32x2 __attribute__((ext_vector_type(2)));

constexpr int DM = 4096, NB = 2, SEQ = 8192, CTX = 256, NL = 2;
constexpr int SB = SEQ + CTX;
constexpr int MROWS = NB * SB;
constexpr int TPB = SB / 256;
constexpr int NIN = 20800, NZ = 20992;
constexpr int ZC_F = 0, ZC_FG = 1024, ZC_Q = 2048, ZC_KV = 2816, ZC_KR = 3328, ZC_MG = 3584, ZC_GA = 5632, ZC_GG = 6656, ZC_CG = 7680,
              ZC_MF = 8704, ZC_MM = 12800, ZC_MC = 16896;
constexpr int NH = 16, DQK = 192, DNOPE = 128, DROPE = 64, DVH = 128, QLORA = 768, KVLORA = 512;
constexpr int FD = 1024, CD = 1024, MLA = 2048, CONVW = 31;
constexpr float EPS = 1e-6f;
constexpr int NWAVES = 8, NTHR = 512;

constexpr size_t al256(size_t x) { return (x + 255) & ~size_t(255); }
constexpr size_t MiB = size_t(1) << 20;
constexpr size_t WS_CTL = 0;
constexpr size_t WS_MOD = 1 * MiB;
constexpr size_t WS_V2 = WS_MOD + al256(size_t(2) * 3 * 12288 * 4);
constexpr size_t ZERO_BYTES = 2 * MiB;
constexpr size_t WS_SPEC = 2 * MiB;
constexpr size_t WS_ROPE = WS_SPEC + 32768;
constexpr size_t WS_CS256 = WS_ROPE + 16384;
constexpr size_t WS_CS = al256(WS_CS256 + 262144);
constexpr size_t WS_COS = WS_CS + 4 * MiB;
constexpr size_t WS_SIN = WS_COS + 32 * MiB;
constexpr size_t WS_W = WS_SIN + 32 * MiB;
constexpr size_t LW_IN = 0, LW_UQ = LW_IN + size_t(NZ) * DM * 2, LW_UKV = LW_UQ + size_t(3072) * 768 * 2, LW_FN = LW_UKV + size_t(4096) * 512 * 2,
                 LW_PW2 = LW_FN + size_t(1024) * 1024 * 2, LW_BR = LW_PW2 + size_t(1024) * 1024 * 2, LW_OUT = LW_BR + size_t(4096) * 4096 * 2,
                 LAYER_W = LW_OUT + size_t(4096) * 4096 * 2;
constexpr size_t WS_H = WS_W + 2 * LAYER_W;
constexpr size_t WS_Z = WS_H + size_t(MROWS) * DM * 2;
constexpr size_t WS_NCQ = WS_Z + size_t(MROWS) * NZ * 2;
constexpr size_t WS_NCKV = WS_NCQ + size_t(MROWS) * 768 * 2;
constexpr size_t WS_EO = WS_NCKV + size_t(MROWS) * 512 * 2;
constexpr size_t WS_CU = WS_EO + size_t(16384) * 1024 * 2;
constexpr size_t WS_QR = WS_CU + size_t(MROWS) * 1024 * 2;
constexpr size_t WS_KVR = WS_QR + size_t(MROWS) * 3072 * 2;
constexpr size_t WS_KN = WS_KVR + size_t(MROWS) * 4096 * 2;
constexpr size_t WS_Y = WS_KN + size_t(MROWS) * 3072 * 2;
constexpr size_t WS_ECOS = WS_Y + size_t(MROWS) * 4096 * 2;
constexpr size_t WS_TCT = WS_ECOS + size_t(2048) * 16384 * 2;
constexpr size_t WS_G12 = WS_TCT + size_t(2048) * 512 * 2;
constexpr size_t WS_ZF = WS_G12 + size_t(16384) * 1024 * 4;
constexpr size_t WS_MRG = WS_ZF + size_t(MROWS) * 1024 * 2;
constexpr size_t WS_XC1 = WS_MRG + size_t(MROWS) * 4096 * 2;
constexpr size_t WS_END = WS_XC1 + size_t(512) * 4096 * 4;

constexpr int CW_TMO = 0, CW_BAR = 4096;

constexpr int RING_BYTES = 131072, LDSCTL_OFF = RING_BYTES, MISC_OFF = LDSCTL_OFF + 320, LDS_BYTES = 147456;

__device__ __forceinline__ float bf_lo(unsigned w) { return __uint_as_float(w << 16); }
__device__ __forceinline__ float bf_hi(unsigned w) { return __uint_as_float(w & 0xffff0000u); }
__device__ __forceinline__ float bf2f(bf16_t b) { return __uint_as_float(((unsigned)b) << 16); }
__device__ __forceinline__ unsigned cvt_pk_bf16(float lo, float hi) { unsigned r; asm volatile("v_cvt_pk_bf16_f32 %0, %1, %2" : "=v"(r) : "v"(lo), "v"(hi)); return r; }
__device__ __forceinline__ bf16_t f2bf(float f) { return (bf16_t)(cvt_pk_bf16(f, 0.f) & 0xffffu); }
__device__ __forceinline__ float sigmoidf_(float x) { return __builtin_amdgcn_rcpf(1.0f + __builtin_amdgcn_exp2f(-1.4426950408889634f * x)); }
template <int O> __device__ __forceinline__ float lane_xor(float v) {
    if constexpr (O == 32) { auto rr = __builtin_amdgcn_permlane32_swap(__float_as_uint(v), __float_as_uint(v), false, false); return __uint_as_float(threadIdx.x & 32 ? rr[0] : rr[1]); }
    else return __uint_as_float((unsigned)__builtin_amdgcn_ds_swizzle((int)__float_as_uint(v), (O << 10) | 0x1F));
}
__device__ __forceinline__ float wave_sum(float v) {
    v += lane_xor<1>(v); v += lane_xor<2>(v); v += lane_xor<4>(v); v += lane_xor<8>(v); v += lane_xor<16>(v);
    { auto rr = __builtin_amdgcn_permlane32_swap(__float_as_uint(v), __float_as_uint(v), false, false); v = __uint_as_float(rr[0]) + __uint_as_float(rr[1]); }
    return v;
}
__device__ __forceinline__ int tid_fresh() { int t = threadIdx.x; asm volatile("" : "+v"(t)); return t; }
__device__ __forceinline__ void unpack8(const u32x4 w, float (&f)[8]) { f[0] = bf_lo(w.x); f[1] = bf_hi(w.x); f[2] = bf_lo(w.y); f[3] = bf_hi(w.y); f[4] = bf_lo(w.z); f[5] = bf_hi(w.z); f[6] = bf_lo(w.w); f[7] = bf_hi(w.w); }
__device__ __forceinline__ u32x4 pack8(const float (&f)[8]) { u32x4 w; w.x = cvt_pk_bf16(f[0], f[1]); w.y = cvt_pk_bf16(f[2], f[3]); w.z = cvt_pk_bf16(f[4], f[5]); w.w = cvt_pk_bf16(f[6], f[7]); return w; }
#define LDS_WAIT() asm volatile("s_waitcnt lgkmcnt(0)" ::: "memory")
#define VM_WAIT() asm volatile("s_waitcnt vmcnt(0)" ::: "memory")

namespace pg8 {
constexpr int BM = 256, BK = 64, HALF = 128, HTB = HALF * BK * 2, STAGE_BYTES = 8 * HTB, NXCD = 8, WGM = 8;
__host__ __device__ __forceinline__ int lds_byte(int r, int c) { const int st = (r >> 4) * 2 + (c >> 5), rr = r & 15, cc = c & 31, ob = rr * 64 + cc * 2; return st * 1024 + (ob ^ (((ob >> 9) & 1) << 5)); }
__host__ __device__ __forceinline__ void stage_rc(int b, int& R, int& C) { const int st = b / 1024, sb = b % 1024, swz = sb ^ (((sb >> 9) & 1) << 5); R = (st >> 1) * 16 + swz / 64; C = (st & 1) * 32 + (swz % 64) / 2; }
__host__ __device__ __forceinline__ int perm32(int rho) { const int n = rho >> 4, i = rho & 15; return 8 * (i >> 2) + 4 * n + (i & 3); }

struct Unit { const char* A; const char* B; int nt; int r0, c0; int aux; };

__device__ __forceinline__ bool order_tile(int i, int G, int c, int nM, int nN, int& pm, int& pn) {
    const int nwg = nM * nN; const long L = (long)i * G + c; if (L >= nwg) return false;
    int wgid = (int)L; { const int q = nwg / NXCD, r = nwg % NXCD, xcd = wgid % NXCD, off = wgid / NXCD; wgid = (xcd < r ? xcd * (q + 1) : r * (q + 1) + (xcd - r) * q) + off; }
    const int nig = WGM * nN, gid = wgid / nig, fm = gid * WGM, gsz = (nM - fm) < WGM ? (nM - fm) : WGM;
    pm = fm + ((wgid % nig) % gsz); pn = (wgid % nig) / gsz; return true;
}

template <class Epi, class Sched, bool ALIGN_EPI = true, bool SP2 = true>
__device__ __forceinline__ void gemm_phase(LAS unsigned char* lds, const Sched& S, const Epi& E, const int lda, const int ldb) {
    const int tid = tid_fresh(), wid = __builtin_amdgcn_readfirstlane(tid >> 6), lane = tid & 63, wr = wid >> 2, wc = wid & 3, fr = lane & 15, fq = lane >> 4;
    unsigned voffA[2], voffB[2];
#pragma unroll
    for (int i = 0; i < 2; ++i) { int R, C; stage_rc(tid * 16 + i * 8192, R, C); const int Rb = Epi::PERM ? ((R & ~31) + perm32(R & 31)) : R;
        voffA[i] = (unsigned)(R * lda + C) * 2u; voffB[i] = (unsigned)(Rb * ldb + C) * 2u; }
    const size_t kstep = (size_t)(BK * 2);
    const size_t hstepA = (size_t)HALF * lda * 2, hstepB = (size_t)HALF * ldb * 2;
    const unsigned ldsw = (unsigned)wid * 1024u;
    const int aoff = lds_byte(wr * 64 + fr, fq * 8), boff = lds_byte(wc * 32 + fr, fq * 8);
#define PG8_SA(b, h) (((b) * 2 + (h)) * HTB)
#define PG8_SB(b, h) ((4 + (b) * 2 + (h)) * HTB)
#define PG8_STAGE(bufoff, gbase, voff) do { _Pragma("unroll") for (int _i = 0; _i < 2; ++_i) \
        __builtin_amdgcn_global_load_lds((const unsigned*)((const char*)(gbase) + (voff)[_i]), (LAS unsigned*)(lds + (bufoff) + ldsw + _i * 8192), 16, 0, 0); } while (0)
#define PG8_LDA(dst, b, h) do { _Pragma("unroll") for (int m = 0; m < 4; ++m) _Pragma("unroll") for (int k = 0; k < 2; ++k) dst[m][k] = *(const LAS bf16x8*)(lds + PG8_SA(b, h) + aoff + m * 2048 + k * 1024); } while (0)
#define PG8_LDB(dst, b, h) do { _Pragma("unroll") for (int n = 0; n < 2; ++n) _Pragma("unroll") for (int k = 0; k < 2; ++k) dst[n][k] = *(const LAS bf16x8*)(lds + PG8_SB(b, h) + boff + n * 2048 + k * 1024); } while (0)
#define PG8_MMA(ai, bj, At, Bt) do { __builtin_amdgcn_s_setprio(1); _Pragma("unroll") for (int m = 0; m < 4; ++m) _Pragma("unroll") for (int n = 0; n < 2; ++n) _Pragma("unroll") for (int k = 0; k < 2; ++k) \
        acc[ai][bj][m][n] = __builtin_amdgcn_mfma_f32_16x16x32_bf16(Bt[n][k], At[m][k], acc[ai][bj][m][n], 0, 0, 0); __builtin_amdgcn_s_setprio(0); } while (0)
#define PG8_WAIT_V(n) asm volatile("s_waitcnt vmcnt(" #n ")" ::: "memory")
#define PG8_WAIT_L(n) asm volatile("s_waitcnt lgkmcnt(" #n ")" ::: "memory")
#define PG8_BAR __builtin_amdgcn_s_barrier()
#define PG8_SCHED __builtin_amdgcn_sched_barrier(0)
    Unit cur, nxt; int ui = 0;
    if (!S.next(0, cur)) return;
    f32x4 acc[2][2][4][2];
#pragma unroll
    for (int a = 0; a < 2; ++a)
#pragma unroll
        for (int b = 0; b < 2; ++b)
#pragma unroll
            for (int m = 0; m < 4; ++m)
#pragma unroll
                for (int n = 0; n < 2; ++n) acc[a][b][m][n] = (f32x4){0.f, 0.f, 0.f, 0.f};
    bf16x8 At[4][2], B0[2][2], B1[2][2];
    const char* cA = cur.A; const char* cB = cur.B;
    if constexpr (SP2) {
        PG8_STAGE(PG8_SB(0, 0), cB, voffB); PG8_STAGE(PG8_SB(0, 1), cB + hstepB, voffB); PG8_STAGE(PG8_SA(0, 0), cA, voffA); PG8_STAGE(PG8_SA(0, 1), cA + hstepA, voffA);
        if (wr == 1) PG8_BAR;
        PG8_WAIT_V(2); PG8_BAR;
        PG8_STAGE(PG8_SB(1, 0), cB + kstep, voffB); PG8_STAGE(PG8_SA(1, 0), cA + kstep, voffA); PG8_STAGE(PG8_SB(1, 1), cB + hstepB + kstep, voffB);
        PG8_WAIT_V(6); PG8_BAR;
    } else {
        PG8_STAGE(PG8_SB(0, 0), cB, voffB); PG8_STAGE(PG8_SA(0, 0), cA, voffA); PG8_STAGE(PG8_SB(0, 1), cB + hstepB, voffB); PG8_STAGE(PG8_SA(0, 1), cA + hstepA, voffA);
        if (wr == 1) PG8_BAR;
        PG8_WAIT_V(4); PG8_BAR;
        PG8_STAGE(PG8_SB(1, 0), cB + kstep, voffB); PG8_STAGE(PG8_SA(1, 0), cA + kstep, voffA); PG8_STAGE(PG8_SB(1, 1), cB + hstepB + kstep, voffB);
        PG8_WAIT_V(6); PG8_BAR;
    }
    for (;;) {
        const bool has_next = S.next(ui + 1, nxt);
        const char* nA = has_next ? nxt.A : cA; const char* nB = has_next ? nxt.B : cB;
        const int nt = cur.nt;
        for (int t = 0; t < nt; t += 2) {
            const bool last = (t == nt - 2);
            const char* a1 = cA + (size_t)(t + 1) * kstep;
            const char* a2 = last ? nA : cA + (size_t)(t + 2) * kstep; const char* b2 = last ? nB : cB + (size_t)(t + 2) * kstep;
            const char* a3 = a2 + kstep; const char* b3 = b2 + kstep;
            if constexpr (SP2) {
            PG8_LDB(B0, 0, 0); PG8_LDB(B1, 0, 1); PG8_SCHED; PG8_LDA(At, 0, 0); PG8_STAGE(PG8_SA(1, 1), a1 + hstepA, voffA);
            PG8_WAIT_V(8); PG8_WAIT_L(0); PG8_BAR; PG8_MMA(0, 0, At, B0); PG8_MMA(0, 1, At, B1); PG8_BAR; PG8_SCHED;
            PG8_LDA(At, 0, 1); PG8_STAGE(PG8_SB(0, 0), b2, voffB); PG8_STAGE(PG8_SB(0, 1), b2 + hstepB, voffB); PG8_STAGE(PG8_SA(0, 0), a2, voffA);
            PG8_WAIT_V(8); PG8_WAIT_L(0); PG8_BAR; PG8_MMA(1, 0, At, B0); PG8_MMA(1, 1, At, B1); PG8_BAR; PG8_SCHED;
            PG8_LDB(B0, 1, 0); PG8_LDB(B1, 1, 1); PG8_SCHED; PG8_LDA(At, 1, 0); PG8_STAGE(PG8_SA(0, 1), a2 + hstepA, voffA);
            PG8_WAIT_V(8); PG8_WAIT_L(0); PG8_BAR; PG8_MMA(0, 0, At, B0); PG8_MMA(0, 1, At, B1); PG8_BAR; PG8_SCHED;
            PG8_LDA(At, 1, 1); PG8_STAGE(PG8_SB(1, 0), b3, voffB); PG8_STAGE(PG8_SB(1, 1), b3 + hstepB, voffB); PG8_STAGE(PG8_SA(1, 0), a3, voffA);
            PG8_WAIT_V(8); PG8_WAIT_L(0); PG8_BAR; PG8_MMA(1, 0, At, B0); PG8_MMA(1, 1, At, B1); PG8_BAR; PG8_SCHED;
            } else {
            PG8_LDB(B0, 0, 0); PG8_SCHED; PG8_LDA(At, 0, 0); PG8_STAGE(PG8_SA(1, 1), a1 + hstepA, voffA);
            PG8_WAIT_L(8); PG8_BAR; PG8_WAIT_L(0); PG8_MMA(0, 0, At, B0); PG8_BAR; PG8_SCHED;
            PG8_LDB(B1, 0, 1); PG8_STAGE(PG8_SB(0, 0), b2, voffB);
            PG8_BAR; PG8_WAIT_L(0); PG8_MMA(0, 1, At, B1); PG8_BAR;
            PG8_LDA(At, 0, 1); PG8_STAGE(PG8_SA(0, 0), a2, voffA);
            PG8_BAR; PG8_WAIT_L(0); PG8_MMA(1, 0, At, B0); PG8_BAR; PG8_SCHED;
            PG8_STAGE(PG8_SB(0, 1), b2 + hstepB, voffB);
            PG8_WAIT_V(6); PG8_BAR; PG8_MMA(1, 1, At, B1); PG8_BAR;
            PG8_LDB(B0, 1, 0); PG8_SCHED; PG8_LDA(At, 1, 0); PG8_STAGE(PG8_SA(0, 1), a2 + hstepA, voffA);
            PG8_WAIT_L(8); PG8_BAR; PG8_WAIT_L(0); PG8_MMA(0, 0, At, B0); PG8_BAR; PG8_SCHED;
            PG8_LDB(B1, 1, 1); PG8_STAGE(PG8_SB(1, 0), b3, voffB);
            PG8_BAR; PG8_WAIT_L(0); PG8_MMA(0, 1, At, B1); PG8_BAR;
            PG8_LDA(At, 1, 1); PG8_STAGE(PG8_SA(1, 0), a3, voffA);
            PG8_BAR; PG8_WAIT_L(0); PG8_MMA(1, 0, At, B0); PG8_BAR; PG8_SCHED;
            PG8_STAGE(PG8_SB(1, 1), b3 + hstepB, voffB);
            PG8_WAIT_V(6); PG8_BAR; PG8_MMA(1, 1, At, B1); PG8_BAR;
            }
        }
        if constexpr (ALIGN_EPI) { if (wr == 0) PG8_BAR; }
        const bool keep = E(acc, cur, wr, wc, fr, fq);
        if (!has_next) break;
        if (!keep) {
#pragma unroll
        for (int a = 0; a < 2; ++a)
#pragma unroll
            for (int b = 0; b < 2; ++b)
#pragma unroll
                for (int m = 0; m < 4; ++m)
#pragma unroll
                    for (int n = 0; n < 2; ++n) acc[a][b][m][n] = (f32x4){0.f, 0.f, 0.f, 0.f};
        }
        cur = nxt; cA = nA; cB = nB; ++ui;
        if constexpr (ALIGN_EPI) { if (wr == 1) PG8_BAR; }
    }
    PG8_WAIT_V(0);
    if constexpr (!ALIGN_EPI) { if (wr == 0) PG8_BAR; }
    PG8_BAR;
#undef PG8_SA
#undef PG8_SB
#undef PG8_STAGE
#undef PG8_LDA
#undef PG8_LDB
#undef PG8_MMA
#undef PG8_WAIT_V
#undef PG8_WAIT_L
#undef PG8_BAR
#undef PG8_SCHED
}

struct TileSched {
    const char* A; const char* B; size_t lda2, ldb2; int nt, mode, nMv, nN, c0base, G, c;
    __device__ __forceinline__ void init(const void* A_, int lda, const void* B_, int ldb, int K, int mode_, int nN_, int c0base_, int G_, int c_) {
        A = (const char*)A_; B = (const char*)B_; lda2 = (size_t)lda * 2; ldb2 = (size_t)ldb * 2; nt = K / 64; mode = mode_; nMv = mode_ == 0 ? 66 : (mode_ == 1 ? 64 : 2); nN = nN_; c0base = c0base_; G = G_; c = c_; }
    __device__ __forceinline__ int units() const { return nMv * nN; }
    __device__ __forceinline__ bool next(int i, Unit& u) const {
        int vm, pn; if (!order_tile(i, G, c, nMv, nN, vm, pn)) return false;
        const int pm = mode == 0 ? vm : (mode == 1 ? vm + 1 + (vm >= 32 ? 1 : 0) : vm * TPB);
        u.A = A + (size_t)pm * 256 * lda2; u.B = B + (size_t)pn * 256 * ldb2; u.nt = nt; u.r0 = pm * 256; u.c0 = c0base + pn * 256; u.aux = 0; return true; }
};
struct MergeSched {
    const char* A; const char* B; int mode, nMv, G, c;
    __device__ __forceinline__ bool next(int i, Unit& u) const {
        const int ti = i / 3, k = i - ti * 3; int vm, pn; if (!order_tile(ti, G, c, nMv, 16, vm, pn)) return false;
        const int pm = mode == 0 ? vm : vm + 1 + (vm >= 32 ? 1 : 0);
        const int p = c % 6, s0 = p >> 1, r = p & 1, s1 = s0 == 0 ? (r ? 2 : 1) : (s0 == 1 ? (r ? 2 : 0) : (r ? 1 : 0)), s2 = 3 - s0 - s1;
        const int seg = k == 0 ? s0 : (k == 1 ? s1 : s2), nxt = k == 0 ? s1 : (k == 1 ? s2 : 3);
        const int koff = seg == 0 ? 0 : (seg == 1 ? 1024 : 3072);
        u.A = A + ((size_t)pm * 256 * 4096 + koff) * 2; u.B = B + ((size_t)pn * 256 * 4096 + koff) * 2; u.nt = seg == 1 ? 32 : 16; u.r0 = pm * 256; u.c0 = pn * 256; u.aux = seg * 4 + nxt; return true; }
};
struct CtxSplitSched {
    const char* A; const char* B; int merge, G, c;
    __device__ __forceinline__ bool next(int i, Unit& u) const {
        const long L = (long)i * G + c; if (L >= 256) return false;
        const int t = (int)L >> 3, ch = (int)L & 7, pmc = t >> 4, pn = t & 15, pm = pmc * TPB, koff = ch * 512;
        u.A = A + ((size_t)pm * 256 * 4096 + koff) * 2; u.B = B + ((size_t)pn * 256 * 4096 + koff) * 2; u.nt = 8; u.r0 = pmc * 256; u.c0 = pn * 256;
        u.aux = ch * 4 + (merge ? (ch < 2 ? 0 : (ch < 6 ? 1 : 2)) : 0); return true; }
};
struct CswSched {
    const char* WfnT; const char* CS; int G, c;
    __device__ __forceinline__ bool next(int i, Unit& u) const {
        const long L = (long)i * G + c; if (L >= 32) return false;
        const int pm = (int)L >> 3, pn = (int)L & 7;
        u.A = WfnT + (size_t)pm * 256 * 1024 * 2; u.B = CS + (size_t)pn * 256 * 1024 * 2; u.nt = 16; u.r0 = (pn >> 2) * 1024 + pm * 256; u.c0 = (pn & 3) * 256; u.aux = 0; return true; }
};
struct FchanSched {
    const char* CS; const char* EO; int G, c;
    __device__ __forceinline__ bool next(int i, Unit& u) const {
        const long L = (long)i * G + c; if (L >= 256) return false;
        const int j = (int)L >> 5, r = (int)L & 31, sn = (j >> 1) & 1, pmm = r >> 3, pns = r & 7;
        u.A = CS + (size_t)(sn * 1024 + pmm * 256) * 1024 * 2; u.B = EO + (size_t)(j * 2048 + pns * 256) * 1024 * 2; u.nt = 16;
        u.r0 = sn * 1024 + pmm * 256; u.c0 = j * 2048 + pns * 256; u.aux = 0; return true; }
};
struct FchanCtxSched {
    const char* CS; const char* Z; int G, c;
    __device__ __forceinline__ bool next(int i, Unit& u) const {
        const long L = (long)i * G + c; if (L >= 16) return false;
        const int b = (int)L >> 3, p8 = (int)L & 7;
        u.A = CS + (size_t)p8 * 256 * 1024 * 2; u.B = Z + ((size_t)b * SB * NZ + ZC_F) * 2; u.nt = 16;
        u.r0 = b * 1024 + (p8 & 3) * 256; u.c0 = (p8 >> 2) * 256; u.aux = 0; return true; }
};
struct FseqSched {
    const char* ws; int G, c;
    __device__ __forceinline__ bool next(int i, Unit& u) const {
        const long L = (long)i * G + c; if (L >= 256) return false;
        const int j = (int)L >> 5, r = (int)L & 31, a = j & 3, sn = a >> 1, pk = r >> 2, pmm = r & 3;
        u.A = ws + WS_COS + (size_t)a * (8 * MiB) + (size_t)pk * 256 * 2048 * 2; u.B = ws + WS_ECOS + ((size_t)(sn * 1024 + pmm * 256) * 16384 + (size_t)j * 2048) * 2; u.nt = 32;
        u.r0 = j * 2048 + pk * 256; u.c0 = pmm * 256; u.aux = 0; return true; }
};
struct FseqCtxSched {
    const char* CS256; const char* TCT; int G, c;
    __device__ __forceinline__ bool next(int i, Unit& u) const {
        const long L = (long)i * G + c; if (L >= 8) return false;
        const int b = (int)L >> 2, pmm = (int)L & 3;
        u.A = CS256; u.B = TCT + (size_t)(b * 1024 + pmm * 256) * 512 * 2; u.nt = 8; u.r0 = b * SB; u.c0 = pmm * 256; u.aux = 0; return true; }
};

__device__ __forceinline__ int zact_of_tile(int pn) {
    if (pn < 4) return 0; if (pn < 8) return 1; if (pn < 14) return 0; if (pn < 22) return 1; if (pn < 26) return 0; if (pn < 30) return 2; if (pn < 34) return 1; return 2; }

struct EpiZ {
    static constexpr bool PERM = true;
    bf16_t* Z;
    __device__ __forceinline__ bool operator()(f32x4 (&acc)[2][2][4][2], const Unit& u, int wr, int wc, int fr, int fq) const {
        const int kind = zact_of_tile(u.c0 >> 8);
        const int row0 = u.r0 + wr * 64 + fr, col0 = u.c0 + wc * 32 + 8 * fq;
#pragma unroll
        for (int ai = 0; ai < 2; ++ai)
#pragma unroll
            for (int m = 0; m < 4; ++m) { bf16_t* rowp = Z + (size_t)(row0 + ai * HALF + m * 16) * NZ + col0;
#pragma unroll
                for (int bj = 0; bj < 2; ++bj) { f32x4 v0 = acc[ai][bj][m][0], v1 = acc[ai][bj][m][1];
                    if (kind) {
#pragma unroll
                        for (int j = 0; j < 4; ++j) { const float s0 = sigmoidf_(v0[j]), s1 = sigmoidf_(v1[j]); v0[j] = kind == 1 ? v0[j] * s0 : s0; v1[j] = kind == 1 ? v1[j] * s1 : s1; } }
                    u32x4 w; w.x = cvt_pk_bf16(v0[0], v0[1]); w.y = cvt_pk_bf16(v0[2], v0[3]); w.z = cvt_pk_bf16(v1[0], v1[1]); w.w = cvt_pk_bf16(v1[2], v1[3]);
                    *(u32x4*)(rowp + bj * HALF) = w; } }
        return false;
    }
};
struct EpiBf16 {
    static constexpr bool PERM = true;
    bf16_t* O; int ldc; float scale;
    __device__ __forceinline__ bool operator()(f32x4 (&acc)[2][2][4][2], const Unit& u, int wr, int wc, int fr, int fq) const {
        const int row0 = u.r0 + wr * 64 + fr, col0 = u.c0 + wc * 32 + 8 * fq;
#pragma unroll
        for (int ai = 0; ai < 2; ++ai)
#pragma unroll
            for (int m = 0; m < 4; ++m) { bf16_t* rowp = O + (size_t)(row0 + ai * HALF + m * 16) * ldc + col0;
#pragma unroll
                for (int bj = 0; bj < 2; ++bj) { const f32x4 v0 = acc[ai][bj][m][0] * scale, v1 = acc[ai][bj][m][1] * scale;
                    u32x4 w; w.x = cvt_pk_bf16(v0[0], v0[1]); w.y = cvt_pk_bf16(v0[2], v0[3]); w.z = cvt_pk_bf16(v1[0], v1[1]); w.w = cvt_pk_bf16(v1[2], v1[3]);
                    *(u32x4*)(rowp + bj * HALF) = w; } }
        return false;
    }
};
struct EpiGate {
    static constexpr bool PERM = true;
    bf16_t* Y; const bf16_t* Z; int ycol, gcol; float scale;
    __device__ __forceinline__ bool operator()(f32x4 (&acc)[2][2][4][2], const Unit& u, int wr, int wc, int fr, int fq) const {
        const int row0 = u.r0 + wr * 64 + fr, col0 = u.c0 + wc * 32 + 8 * fq;
        u32x4 g[2][4][2];
#pragma unroll
        for (int ai = 0; ai < 2; ++ai)
#pragma unroll
            for (int m = 0; m < 4; ++m) { const size_t r = (size_t)(row0 + ai * HALF + m * 16);
#pragma unroll
                for (int bj = 0; bj < 2; ++bj) g[ai][m][bj] = *(const u32x4*)(Z + r * NZ + gcol + col0 + bj * HALF); }
        __builtin_amdgcn_sched_barrier(0);
#pragma unroll
        for (int ai = 0; ai < 2; ++ai)
#pragma unroll
            for (int m = 0; m < 4; ++m) { const size_t r = (size_t)(row0 + ai * HALF + m * 16);
#pragma unroll
                for (int bj = 0; bj < 2; ++bj) { const u32x4 gg = g[ai][m][bj];
                    const f32x4 v0 = acc[ai][bj][m][0] * scale, v1 = acc[ai][bj][m][1] * scale;
                    u32x4 w; w.x = cvt_pk_bf16(v0[0] * bf_lo(gg.x), v0[1] * bf_hi(gg.x)); w.y = cvt_pk_bf16(v0[2] * bf_lo(gg.y), v0[3] * bf_hi(gg.y));
                    w.z = cvt_pk_bf16(v1[0] * bf_lo(gg.z), v1[1] * bf_hi(gg.z)); w.w = cvt_pk_bf16(v1[2] * bf_lo(gg.w), v1[3] * bf_hi(gg.w));
                    *(u32x4*)(Y + r * 4096 + ycol + col0 + bj * HALF) = w; } }
        return false;
    }
};
struct EpiF32 {
    static constexpr bool PERM = false;
    float* C; int ldc;
    __device__ __forceinline__ bool operator()(f32x4 (&acc)[2][2][4][2], const Unit& u, int wr, int wc, int fr, int fq) const {
        const int row0 = u.r0 + wr * 64 + fr, col0 = u.c0 + wc * 32 + 4 * fq;
#pragma unroll
        for (int ai = 0; ai < 2; ++ai)
#pragma unroll
            for (int m = 0; m < 4; ++m) { float* rowp = C + (size_t)(row0 + ai * HALF + m * 16) * ldc + col0;
#pragma unroll
                for (int bj = 0; bj < 2; ++bj)
#pragma unroll
                    for (int n = 0; n < 2; ++n) *(f32x4*)(rowp + bj * HALF + n * 16) = acc[ai][bj][m][n]; }
        return false;
    }
};
struct EpiMerge {
    static constexpr bool PERM = true;
    bf16_t* O; const bf16_t* Z;
    __device__ __forceinline__ bool operator()(f32x4 (&acc)[2][2][4][2], const Unit& u, int wr, int wc, int fr, int fq) const {
        const int row0 = u.r0 + wr * 64 + fr, col0 = u.c0 + wc * 32 + 8 * fq; const int cur = u.aux >> 2, nxt = u.aux & 3; const bool last = nxt == 3;
        const int gnum = cur == 0 ? ZC_MF : (cur == 1 ? ZC_MM : ZC_MC), gden = nxt == 0 ? ZC_MF : (nxt == 1 ? ZC_MM : ZC_MC);
#pragma unroll
        for (int ai = 0; ai < 2; ++ai) {
            u32x4 gn[4][2], gd[4][2];
#pragma unroll
            for (int m = 0; m < 4; ++m)
#pragma unroll
                for (int bj = 0; bj < 2; ++bj) { const size_t r = (size_t)(row0 + ai * HALF + m * 16);
                    gn[m][bj] = *(const u32x4*)(Z + r * NZ + gnum + col0 + bj * HALF);
                    gd[m][bj] = last ? (u32x4){0x3f803f80u, 0x3f803f80u, 0x3f803f80u, 0x3f803f80u} : *(const u32x4*)(Z + r * NZ + gden + col0 + bj * HALF); }
            __builtin_amdgcn_sched_barrier(0);
#pragma unroll
            for (int m = 0; m < 4; ++m)
#pragma unroll
                for (int bj = 0; bj < 2; ++bj) { const size_t r = (size_t)(row0 + ai * HALF + m * 16);
                    const u32x4 a = gn[m][bj], d = gd[m][bj];
                    float f[8] = {bf_lo(a.x), bf_hi(a.x), bf_lo(a.y), bf_hi(a.y), bf_lo(a.z), bf_hi(a.z), bf_lo(a.w), bf_hi(a.w)};
                    if (!last) { const float dd[8] = {bf_lo(d.x), bf_hi(d.x), bf_lo(d.y), bf_hi(d.y), bf_lo(d.z), bf_hi(d.z), bf_lo(d.w), bf_hi(d.w)};
#pragma unroll
                        for (int j = 0; j < 8; ++j) f[j] = f[j] * __builtin_amdgcn_rcpf(fmaxf(dd[j], 1e-30f)); }
                    f32x4 v0 = acc[ai][bj][m][0], v1 = acc[ai][bj][m][1];
#pragma unroll
                    for (int j = 0; j < 4; ++j) { v0[j] *= f[j]; v1[j] *= f[4 + j]; }
                    if (!last) { acc[ai][bj][m][0] = v0; acc[ai][bj][m][1] = v1; }
                    else { u32x4 w; w.x = cvt_pk_bf16(v0[0], v0[1]); w.y = cvt_pk_bf16(v0[2], v0[3]); w.z = cvt_pk_bf16(v1[0], v1[1]); w.w = cvt_pk_bf16(v1[2], v1[3]);
                        *(u32x4*)(O + r * 4096 + col0 + bj * HALF) = w; } }
            __builtin_amdgcn_sched_barrier(0);
        }
        return !last;
    }
};
struct EpiMergePart {
    static constexpr bool PERM = true;
    float* PART; const bf16_t* Z;
    __device__ __forceinline__ bool operator()(f32x4 (&acc)[2][2][4][2], const Unit& u, int wr, int wc, int fr, int fq) const {
        const int ch = u.aux >> 2, seg = u.aux & 3, gcol = seg == 0 ? ZC_MF : (seg == 1 ? ZC_MM : ZC_MC);
        const int pmc = u.r0 >> 8; const size_t zrow0 = (size_t)pmc * SB;
        const int rl0 = wr * 64 + fr, col0 = u.c0 + wc * 32 + 8 * fq;
        float* P = PART + ((size_t)ch * 512 + u.r0) * 4096;
        u32x4 g[2][4][2];
#pragma unroll
        for (int ai = 0; ai < 2; ++ai)
#pragma unroll
            for (int m = 0; m < 4; ++m)
#pragma unroll
                for (int bj = 0; bj < 2; ++bj) g[ai][m][bj] = *(const u32x4*)(Z + (zrow0 + rl0 + ai * HALF + m * 16) * NZ + gcol + col0 + bj * HALF);
        __builtin_amdgcn_sched_barrier(0);
#pragma unroll
        for (int ai = 0; ai < 2; ++ai)
#pragma unroll
            for (int m = 0; m < 4; ++m)
#pragma unroll
                for (int bj = 0; bj < 2; ++bj) { const u32x4 gg = g[ai][m][bj]; const f32x4 v0 = acc[ai][bj][m][0], v1 = acc[ai][bj][m][1];
                    float* dst = P + (size_t)(rl0 + ai * HALF + m * 16) * 4096 + col0 + bj * HALF;
                    *(f32x4*)dst = (f32x4){v0[0] * bf_lo(gg.x), v0[1] * bf_hi(gg.x), v0[2] * bf_lo(gg.y), v0[3] * bf_hi(gg.y)};
                    *(f32x4*)(dst + 4) = (f32x4){v1[0] * bf_lo(gg.z), v1[1] * bf_hi(gg.z), v1[2] * bf_lo(gg.w), v1[3] * bf_hi(gg.w)}; }
        return false;
    }
};
struct EpiOutPart {
    static constexpr bool PERM = false;
    float* PART; const float* mod;
    __device__ __forceinline__ bool operator()(f32x4 (&acc)[2][2][4][2], const Unit& u, int wr, int wc, int fr, int fq) const {
        const int ch = u.aux >> 2; const float* gate = mod + (size_t)2 * 12288 + 2 * DM;
        const int rl0 = wr * 64 + fr, col0 = u.c0 + wc * 32 + 4 * fq;
        float* P = PART + ((size_t)ch * 512 + u.r0) * 4096;
#pragma unroll
        for (int bj = 0; bj < 2; ++bj)
#pragma unroll
            for (int n = 0; n < 2; ++n) { const f32x4 gv = *(const f32x4*)(gate + col0 + bj * HALF + n * 16);
#pragma unroll
                for (int ai = 0; ai < 2; ++ai)
#pragma unroll
                    for (int m = 0; m < 4; ++m) *(f32x4*)(P + (size_t)(rl0 + ai * HALF + m * 16) * 4096 + col0 + bj * HALF + n * 16) = gv * acc[ai][bj][m][n]; }
        return false;
    }
};
struct EpiOut {
    static constexpr bool PERM = false;
    const float* xl_old; const float* xc_old; float* xl_new; float* xc_new; const float* mod;
    __device__ __forceinline__ bool operator()(f32x4 (&acc)[2][2][4][2], const Unit& u, int wr, int wc, int fr, int fq) const {
        const int pm = u.r0 >> 8, b = pm / TPB, pt = pm - b * TPB; const bool isctx = pt == 0;
        const float* src = isctx ? xc_old + (size_t)b * CTX * DM : xl_old + ((size_t)b * SEQ + (size_t)(pt - 1) * 256) * DM;
        float* dst = isctx ? xc_new + (size_t)b * CTX * DM : xl_new + ((size_t)b * SEQ + (size_t)(pt - 1) * 256) * DM;
        const float* gate = mod + (size_t)(isctx ? 2 : b) * 12288 + 2 * DM;
        const int row0 = wr * 64 + fr, col0 = u.c0 + wc * 32 + 4 * fq;
        f32x4 gv[2][2];
#pragma unroll
        for (int bj = 0; bj < 2; ++bj)
#pragma unroll
            for (int n = 0; n < 2; ++n) gv[bj][n] = *(const f32x4*)(gate + col0 + bj * HALF + n * 16);
#pragma unroll
        for (int ai = 0; ai < 2; ++ai) {
            f32x4 xo[4][2][2];
#pragma unroll
            for (int m = 0; m < 4; ++m) { const size_t off = (size_t)(row0 + ai * HALF + m * 16) * DM + col0;
#pragma unroll
                for (int bj = 0; bj < 2; ++bj)
#pragma unroll
                    for (int n = 0; n < 2; ++n) xo[m][bj][n] = *(const f32x4*)(src + off + bj * HALF + n * 16); }
#pragma unroll
            for (int m = 0; m < 4; ++m)
#pragma unroll
                for (int bj = 0; bj < 2; ++bj)
#pragma unroll
                    for (int n = 0; n < 2; ++n) acc[ai][bj][m][n] = xo[m][bj][n] + gv[bj][n] * acc[ai][bj][m][n];
        }
#pragma unroll
        for (int ai = 0; ai < 2; ++ai)
#pragma unroll
            for (int m = 0; m < 4; ++m) { const size_t off = (size_t)(row0 + ai * HALF + m * 16) * DM + col0;
#pragma unroll
                for (int bj = 0; bj < 2; ++bj)
#pragma unroll
                    for (int n = 0; n < 2; ++n) *(f32x4*)(dst + off + bj * HALF + n * 16) = acc[ai][bj][m][n]; }
        return false;
    }
};
}

namespace att {
constexpr int NW = 8, QBLK = 32, KVBLK = 64;
constexpr float SCALE = 0.07216878364870322f;
constexpr float THR = 8.f;
constexpr int LDQ = 3072, LDK = 3072, LDV = 4096;
constexpr int SHM_V = KVBLK * DVH * 2, SHM_K = KVBLK * DQK * 2;
constexpr int SHM_QR = 2 * SHM_V + 2 * SHM_K + NW * 64 * 4;
constexpr int SHM_ATTN = SHM_QR + NW * 4096;
#ifndef ATT_SDEPTH
#define ATT_SDEPTH 1
#endif
constexpr int SDEPTH = ATT_SDEPTH;
#define KSWZ(row, colB) ((row) * 384 + ((colB) ^ ((((row) >> 1) & 7) << 4)))
#define SBAR() __builtin_amdgcn_sched_barrier(0)
__device__ __forceinline__ int crow(int r, int hi) { return (r & 3) + 8 * (r >> 2) + 4 * hi; }
__device__ __forceinline__ void partialSM(f32x16& p0, f32x16& p1, float& m_reg, float& mn, float& alpha) {
  constexpr float C = SCALE * 1.4426950408889634f;
  float pmax = p0[0];
#pragma unroll
  for (int r = 1; r < 16; ++r) pmax = fmaxf(pmax, p0[r]);
#pragma unroll
  for (int r = 0; r < 16; ++r) pmax = fmaxf(pmax, p1[r]);
  { auto rr = __builtin_amdgcn_permlane32_swap(__float_as_uint(pmax), __float_as_uint(pmax), false, false);
    pmax = fmaxf(__uint_as_float(rr[0]), __uint_as_float(rr[1])); }
  if (__builtin_expect(__all(pmax - m_reg <= THR / SCALE), 1)) { mn = m_reg; alpha = 1.f; }
  else { mn = fmaxf(m_reg, pmax); alpha = __builtin_amdgcn_exp2f((m_reg - mn) * C); m_reg = mn; }
  float mnC = -mn * C;
#pragma unroll
  for (int r = 0; r < 16; ++r) p0[r] = fmaf(p0[r], C, mnC);
#pragma unroll
  for (int r = 0; r < 16; ++r) p1[r] = fmaf(p1[r], C, mnC);
#pragma unroll
  for (int r = 0; r < 16; ++r) p0[r] = __builtin_amdgcn_exp2f(p0[r]);
}
__device__ __forceinline__ void partialSM_fix(f32x16& p0, f32x16& p1) {
#pragma unroll
  for (int r = 0; r < 16; ++r) p0[r] = __builtin_amdgcn_exp2f(p0[r]);
}
__device__ __forceinline__ void finishSM_fix(f32x16& p0, f32x16& p1, float& l_lane, bf16x8& pa0, bf16x8& pa1, bf16x8& pa2, bf16x8& pa3) {
#pragma unroll
  for (int r = 0; r < 16; ++r) p1[r] = __builtin_amdgcn_exp2f(p1[r]);
  float ps = 0;
#pragma unroll
  for (int r = 0; r < 16; ++r) ps += p0[r];
#pragma unroll
  for (int r = 0; r < 16; ++r) ps += p1[r];
  l_lane += ps;
#define PK4(P, BASE, OUT) do { unsigned a0 = cvt_pk_bf16(P[BASE + 0], P[BASE + 1]), a1 = cvt_pk_bf16(P[BASE + 2], P[BASE + 3]);   \
    unsigned b0 = cvt_pk_bf16(P[BASE + 4], P[BASE + 5]), b1 = cvt_pk_bf16(P[BASE + 6], P[BASE + 7]);                              \
    auto r0 = __builtin_amdgcn_permlane32_swap(a0, b0, false, false); auto r1 = __builtin_amdgcn_permlane32_swap(a1, b1, false, false); \
    u32x4 w = {r0[0], r1[0], r0[1], r1[1]}; OUT = *reinterpret_cast<bf16x8*>(&w); } while (0)
  PK4(p0, 0, pa0); PK4(p0, 8, pa1); PK4(p1, 0, pa2); PK4(p1, 8, pa3);
#undef PK4
}
__device__ __forceinline__ void finishSM(f32x16& p0, f32x16& p1, float alpha, float& l_reg, bf16x8& pa0, bf16x8& pa1, bf16x8& pa2, bf16x8& pa3) {
#pragma unroll
  for (int r = 0; r < 16; ++r) p1[r] = __builtin_amdgcn_exp2f(p1[r]);
  float ps = 0;
#pragma unroll
  for (int r = 0; r < 16; ++r) ps += p0[r];
#pragma unroll
  for (int r = 0; r < 16; ++r) ps += p1[r];
  { auto rr = __builtin_amdgcn_permlane32_swap(__float_as_uint(ps), __float_as_uint(ps), false, false);
    ps = __uint_as_float(rr[0]) + __uint_as_float(rr[1]); }
  l_reg = l_reg * alpha + ps;
#define PK4(P, BASE, OUT) do { unsigned a0 = cvt_pk_bf16(P[BASE + 0], P[BASE + 1]), a1 = cvt_pk_bf16(P[BASE + 2], P[BASE + 3]);   \
    unsigned b0 = cvt_pk_bf16(P[BASE + 4], P[BASE + 5]), b1 = cvt_pk_bf16(P[BASE + 6], P[BASE + 7]);                              \
    auto r0 = __builtin_amdgcn_permlane32_swap(a0, b0, false, false); auto r1 = __builtin_amdgcn_permlane32_swap(a1, b1, false, false); \
    u32x4 w = {r0[0], r1[0], r0[1], r1[1]}; OUT = *reinterpret_cast<bf16x8*>(&w); } while (0)
  PK4(p0, 0, pa0); PK4(p0, 8, pa1); PK4(p1, 0, pa2); PK4(p1, 8, pa3);
#undef PK4
}
__device__ __forceinline__ void qkt(f32x16& p0, f32x16& p1, const char* Ks, const bf16x8 (&qr)[8], const char* qrope, const int (&kb)[4]) {
  p0 = f32x16{}; p1 = f32x16{};
#define KLD(d, half) (*reinterpret_cast<const bf16x8*>(Ks + kb[(d) & 3] + ((d) >> 2) * 128 + (half) * (32 * 384)))
  bf16x8 c0 = KLD(0, 0), c1 = KLD(0, 1), cq = qr[0];
#pragma unroll
  for (int d0 = 0; d0 < 12; ++d0) {
    bf16x8 n0 = c0, n1 = c1, nq = cq;
    if (d0 < 11) { n0 = KLD(d0 + 1, 0); n1 = KLD(d0 + 1, 1); nq = (d0 + 1 < 8) ? qr[(d0 + 1 < 8) ? d0 + 1 : 0] : *reinterpret_cast<const bf16x8*>(qrope + (d0 + 1 - 8) * 1024); }
    __builtin_amdgcn_sched_group_barrier(0x100, 3, 0);
    p0 = __builtin_amdgcn_mfma_f32_32x32x16_bf16(c0, cq, p0, 0, 0, 0);
    p1 = __builtin_amdgcn_mfma_f32_32x32x16_bf16(c1, cq, p1, 0, 0, 0);
    __builtin_amdgcn_sched_group_barrier(0x008, 2, 0);
    c0 = n0; c1 = n1; cq = nq; }
#undef KLD
}
__device__ __forceinline__ int v_st(int k, int c) { const int kk = (k & ~0xC) | ((k & 4) << 1) | ((k & 8) >> 1); return ((kk >> 3) * 4 + (c >> 5)) * 512 + ((kk & 7) * 32 + (c & 31)) * 2; }
__device__ __forceinline__ int v_rd_base(int lane) { return ((lane & 3) << 3) | (((lane >> 2) & 3) << 6) | (((lane >> 4) & 1) << 5) | (((lane >> 5) & 1) << 8); }
constexpr int v_rd_off(int d0, int ks, int half) { return d0 * 512 + ks * 4096 + half * 2048; }
template <int OFF> __device__ __forceinline__ s16x4 tr_read(int vb) {
  s16x4 r; asm volatile("ds_read_b64_tr_b16 %0, %1 offset:%2" : "=&v"(r) : "v"(vb), "i"(OFF) : "memory"); return r;
}
template <int D0> __device__ __forceinline__ void pv_one(f32x16& od, int vb, bf16x8 pa0, bf16x8 pa1, bf16x8 pa2, bf16x8 pa3) {
  const s16x4 l0 = tr_read<v_rd_off(D0, 0, 0)>(vb), h0 = tr_read<v_rd_off(D0, 0, 1)>(vb), l1 = tr_read<v_rd_off(D0, 1, 0)>(vb), h1 = tr_read<v_rd_off(D0, 1, 1)>(vb);
  const s16x4 l2 = tr_read<v_rd_off(D0, 2, 0)>(vb), h2 = tr_read<v_rd_off(D0, 2, 1)>(vb), l3 = tr_read<v_rd_off(D0, 3, 0)>(vb), h3 = tr_read<v_rd_off(D0, 3, 1)>(vb);
  asm volatile("s_waitcnt lgkmcnt(0)" ::: "memory"); SBAR();
#define PK(L, H) (bf16x8){L[0], L[1], L[2], L[3], H[0], H[1], H[2], H[3]}
  od = __builtin_amdgcn_mfma_f32_32x32x16_bf16(pa0, PK(l0, h0), od, 0, 0, 0);
  od = __builtin_amdgcn_mfma_f32_32x32x16_bf16(pa1, PK(l1, h1), od, 0, 0, 0);
  od = __builtin_amdgcn_mfma_f32_32x32x16_bf16(pa2, PK(l2, h2), od, 0, 0, 0);
  od = __builtin_amdgcn_mfma_f32_32x32x16_bf16(pa3, PK(l3, h3), od, 0, 0, 0);
#undef PK
}
__device__ __forceinline__ void pv_d0(f32x16 (&o)[4], int vb, bf16x8 pa0, bf16x8 pa1, bf16x8 pa2, bf16x8 pa3) {
  pv_one<0>(o[0], vb, pa0, pa1, pa2, pa3); pv_one<1>(o[1], vb, pa0, pa1, pa2, pa3); pv_one<2>(o[2], vb, pa0, pa1, pa2, pa3); pv_one<3>(o[3], vb, pa0, pa1, pa2, pa3);
}

__device__ __forceinline__ void attn_unit(const bf16_t* __restrict__ Qb, const bf16_t* __restrict__ Kh, const bf16_t* __restrict__ Vh, int seq, char* lds,
                                          const bf16_t* __restrict__ gate, bf16_t* __restrict__ Yo) {
  const int tid = tid_fresh(), wid = tid >> 6, lane = tid & 63, r32 = lane & 31, hi = lane >> 5;
  char* V_lds = lds; char* K_lds = lds + 2 * SHM_V;
  float* ws = (float*)(lds + 2 * SHM_V + 2 * SHM_K) + wid * 64; float* li_l = ws; float* al_l = ws + 32;
  float m_reg = -1e30f, l_reg = 0; f32x16 o[4] = {}; bf16x8 qr[8];
  const bf16_t* Qw = Qb + (long)(wid * QBLK + r32) * LDQ + hi * 8;
  char* qrope = lds + SHM_QR + wid * 4096 + lane * 16;
  int kb[4];
#pragma unroll
  for (int d = 0; d < 4; ++d) kb[d] = r32 * 384 + (((d * 2 + hi) ^ ((r32 >> 1) & 7)) << 4);
#pragma unroll
  for (int d0 = 0; d0 < 8; ++d0) qr[d0] = *reinterpret_cast<const bf16x8*>(Qw + d0 * 16);
#pragma unroll
  for (int d0 = 8; d0 < 12; ++d0) *reinterpret_cast<bf16x8*>(qrope + (d0 - 8) * 1024) = *reinterpret_cast<const bf16x8*>(Qw + d0 * 16);
  const int sr = tid >> 4, sc = (tid & 15) * 8, vst0 = v_st(sr, sc), vst1 = v_st(32 + sr, sc);
  unsigned kvo[3], klo[3];
#pragma unroll
  for (int i = 0; i < 3; ++i) { const int q = tid + 512 * i, kr = q / 24, kc = q - kr * 24; kvo[i] = (unsigned)(kr * LDK + kc * 8) * 2u; klo[i] = (unsigned)KSWZ(kr, kc * 16); }
  const unsigned vvo0 = (unsigned)(sr * LDV + sc) * 2u, vvo1 = (unsigned)((32 + sr) * LDV + sc) * 2u;
  const int vb0 = (int)(uintptr_t)V_lds + v_rd_base(lane);
  struct { bf16x8 vs0, vs1, ks0, ks1, ks2; } sr_[SDEPTH];
#define SLOAD(i, k0) do { const char* Vt_ = (const char*)Vh + (size_t)(k0) * (LDV * 2); const char* Kt_ = (const char*)Kh + (size_t)(k0) * (LDK * 2); \
    sr_[i].vs0 = *reinterpret_cast<const bf16x8*>(Vt_ + vvo0); sr_[i].vs1 = *reinterpret_cast<const bf16x8*>(Vt_ + vvo1); \
    sr_[i].ks0 = *reinterpret_cast<const bf16x8*>(Kt_ + kvo[0]); sr_[i].ks1 = *reinterpret_cast<const bf16x8*>(Kt_ + kvo[1]); sr_[i].ks2 = *reinterpret_cast<const bf16x8*>(Kt_ + kvo[2]); } while (0)
#define SWRITE(b, i) do { *(bf16x8*)(V_lds + (b) * SHM_V + vst0) = sr_[i].vs0; *(bf16x8*)(V_lds + (b) * SHM_V + vst1) = sr_[i].vs1; \
    *(bf16x8*)(K_lds + (b) * SHM_K + klo[0]) = sr_[i].ks0; *(bf16x8*)(K_lds + (b) * SHM_K + klo[1]) = sr_[i].ks1; *(bf16x8*)(K_lds + (b) * SHM_K + klo[2]) = sr_[i].ks2; } while (0)
#define SWAIT() do { if constexpr (SDEPTH == 2) asm volatile("s_waitcnt vmcnt(5)" ::: "memory"); else asm volatile("s_waitcnt vmcnt(0)" ::: "memory"); } while (0)
#define RESC(a) do { if (__any((a) < 1.f)) { if (hi == 0) al_l[r32] = (a); asm volatile("s_waitcnt lgkmcnt(0)" ::: "memory"); \
    _Pragma("unroll") for (int d = 0; d < 4; ++d) _Pragma("unroll") for (int r = 0; r < 16; ++r) o[d][r] *= al_l[crow(r, hi)]; } } while (0)
  f32x16 pA0, pA1, pB0, pB1; float mnA, mnB, alA, alB; bf16x8 pa0, pa1, pa2, pa3; const int NT = seq / KVBLK;
  constexpr int SE = 0, SO = SDEPTH - 1;
  SLOAD(SE, 0); asm volatile("s_waitcnt vmcnt(0)" ::: "memory"); SWRITE(0, SE); __syncthreads();
  qkt(pA0, pA1, K_lds, qr, qrope, kb); partialSM(pA0, pA1, m_reg, mnA, alA);
  SLOAD(SO, KVBLK); if constexpr (SDEPTH == 2) { if (2 < NT) SLOAD(SE, 2 * KVBLK); }
  SWAIT(); SWRITE(1, SO); __syncthreads();
  for (int j = 1; j + 1 < NT; j += 2) {
    SBAR(); qkt(pB0, pB1, K_lds + SHM_K, qr, qrope, kb);
    finishSM(pA0, pA1, alA, l_reg, pa0, pa1, pa2, pa3); SBAR();
    SLOAD(SO, (j + SDEPTH) * KVBLK); SBAR();
    pv_d0(o, vb0, pa0, pa1, pa2, pa3); partialSM(pB0, pB1, m_reg, mnB, alB);
    __syncthreads(); SWAIT(); SWRITE(0, SE);
    RESC(alB); __syncthreads();
    SBAR(); qkt(pA0, pA1, K_lds, qr, qrope, kb);
    finishSM(pB0, pB1, alB, l_reg, pa0, pa1, pa2, pa3); SBAR();
    if (SDEPTH == 1 || j + 3 < NT) SLOAD(SE, (j + 1 + SDEPTH) * KVBLK); SBAR();
    pv_d0(o, vb0 + SHM_V, pa0, pa1, pa2, pa3); partialSM(pA0, pA1, m_reg, mnA, alA);
    __syncthreads(); SWAIT(); SWRITE(1, SO);
    RESC(alA); __syncthreads();
  }
  SBAR(); qkt(pB0, pB1, K_lds + SHM_K, qr, qrope, kb);
  finishSM(pA0, pA1, alA, l_reg, pa0, pa1, pa2, pa3); SBAR();
  pv_d0(o, vb0, pa0, pa1, pa2, pa3); partialSM(pB0, pB1, m_reg, mnB, alB);
  __syncthreads(); RESC(alB);
  finishSM(pB0, pB1, alB, l_reg, pa0, pa1, pa2, pa3); SBAR();
  pv_d0(o, vb0 + SHM_V, pa0, pa1, pa2, pa3);
  if (hi == 0) li_l[r32] = l_reg; asm volatile("s_waitcnt lgkmcnt(0)" ::: "memory");
  __syncthreads();
  {
    constexpr int RS = 272;
    int tid_e = threadIdx.x; asm volatile("" : "+v"(tid_e));
    const int wid = tid_e >> 6, lane = tid_e & 63, r32 = lane & 31, hi = lane >> 5;
    char* Ost = lds + wid * (32 * RS);
#pragma unroll
    for (int r = 0; r < 16; ++r) { const int rw = crow(r, hi); const float rl = __builtin_amdgcn_rcpf(li_l[rw]);
#pragma unroll
      for (int d0 = 0; d0 < 4; ++d0) *(bf16_t*)(Ost + rw * RS + (d0 * 32 + r32) * 2) = f2bf(o[d0][r] * rl); }
    asm volatile("s_waitcnt lgkmcnt(0)" ::: "memory");
#pragma unroll
    for (int i = 0; i < 8; ++i) { const int q = lane + 64 * i, row = q >> 4, cc = q & 15; const long orow = wid * QBLK + row;
      const u32x4 ov = *(const u32x4*)(Ost + row * RS + cc * 16); const u32x4 gv = *(const u32x4*)(gate + orow * NZ + cc * 8);
      u32x4 w; w.x = cvt_pk_bf16(bf_lo(ov.x) * bf_lo(gv.x), bf_hi(ov.x) * bf_hi(gv.x)); w.y = cvt_pk_bf16(bf_lo(ov.y) * bf_lo(gv.y), bf_hi(ov.y) * bf_hi(gv.y));
      w.z = cvt_pk_bf16(bf_lo(ov.z) * bf_lo(gv.z), bf_hi(ov.z) * bf_hi(gv.z)); w.w = cvt_pk_bf16(bf_lo(ov.w) * bf_lo(gv.w), bf_hi(ov.w) * bf_hi(gv.w));
      *(u32x4*)(Yo + orow * 4096 + cc * 8) = w; }
  }
  __syncthreads();
#undef SLOAD
#undef SWRITE
#undef SWAIT
#undef RESC
}

constexpr int DMA_KRING = 0, DMA_VRING = 3 * SHM_K, DMA_WS = 3 * SHM_K + 3 * SHM_V, SHM_ATTN_DMA = DMA_WS + NW * 64 * 4;
__device__ __forceinline__ void qkt12(f32x16& p0, f32x16& p1, const char* Ks, const bf16x8 (&qr)[12], const int (&kb)[4]) {
  p0 = f32x16{}; p1 = f32x16{};
#define KLD(d, half) (*reinterpret_cast<const bf16x8*>(Ks + kb[(d) & 3] + ((d) >> 2) * 128 + (half) * (32 * 384)))
  bf16x8 c0 = KLD(0, 0), c1 = KLD(0, 1);
#pragma unroll
  for (int d0 = 0; d0 < 12; ++d0) {
    bf16x8 n0 = c0, n1 = c1;
    if (d0 < 11) { n0 = KLD(d0 + 1, 0); n1 = KLD(d0 + 1, 1); }
    __builtin_amdgcn_sched_group_barrier(0x100, 2, 0);
    p0 = __builtin_amdgcn_mfma_f32_32x32x16_bf16(c0, qr[d0], p0, 0, 0, 0);
    p1 = __builtin_amdgcn_mfma_f32_32x32x16_bf16(c1, qr[d0], p1, 0, 0, 0);
    __builtin_amdgcn_sched_group_barrier(0x008, 2, 0);
    c0 = n0; c1 = n1; }
#undef KLD
}
__device__ __forceinline__ void attn_unit_dma(const bf16_t* __restrict__ Qb, const bf16_t* __restrict__ Kh, const bf16_t* __restrict__ Vh, int seq, char* lds, LAS unsigned char* ldsl,
                                              const bf16_t* __restrict__ gate, bf16_t* __restrict__ Yo, const float* __restrict__ gq, const float* __restrict__ rope, int tok0) {
  const int tid = tid_fresh(), wid = __builtin_amdgcn_readfirstlane(tid >> 6), lane = tid & 63, r32 = lane & 31, hi = lane >> 5;
  float* li_l = (float*)(lds + DMA_WS) + wid * 64;
  float l_reg = 0; f32x16 o[4] = {}; bf16x8 qr[12];
  const bf16_t* Qw = Qb + (long)(wid * QBLK + r32) * LDQ + hi * 8;
#pragma unroll
  for (int d0 = 0; d0 < 12; ++d0) qr[d0] = *reinterpret_cast<const bf16x8*>(Qw + d0 * 16);
  {
    float ss = 0.f;
#pragma unroll
    for (int d0 = 0; d0 < 12; ++d0) { const u32x4 w = *reinterpret_cast<const u32x4*>(&qr[d0]); float f[8]; f[0] = bf_lo(w.x); f[1] = bf_hi(w.x); f[2] = bf_lo(w.y); f[3] = bf_hi(w.y); f[4] = bf_lo(w.z); f[5] = bf_hi(w.z); f[6] = bf_lo(w.w); f[7] = bf_hi(w.w);
#pragma unroll
      for (int e = 0; e < 8; ++e) ss += f[e] * f[e]; }
    { auto rr_ = __builtin_amdgcn_permlane32_swap(__float_as_uint(ss), __float_as_uint(ss), false, false); ss = __uint_as_float(rr_[0]) + __uint_as_float(rr_[1]); }
    const float rstd = rsqrtf(ss * (1.0f / DQK) + EPS) * (SCALE * 1.4426950408889634f);
#pragma unroll
    for (int d0 = 0; d0 < 8; ++d0) { const u32x4 w = *reinterpret_cast<const u32x4*>(&qr[d0]); float f[8]; f[0] = bf_lo(w.x); f[1] = bf_hi(w.x); f[2] = bf_lo(w.y); f[3] = bf_hi(w.y); f[4] = bf_lo(w.z); f[5] = bf_hi(w.z); f[6] = bf_lo(w.w); f[7] = bf_hi(w.w);
      const f32x4 g0 = *(const f32x4*)(gq + d0 * 16 + hi * 8), g1 = *(const f32x4*)(gq + d0 * 16 + hi * 8 + 4);
      u32x4 o; o.x = cvt_pk_bf16(f[0] * rstd * g0[0], f[1] * rstd * g0[1]); o.y = cvt_pk_bf16(f[2] * rstd * g0[2], f[3] * rstd * g0[3]); o.z = cvt_pk_bf16(f[4] * rstd * g1[0], f[5] * rstd * g1[1]); o.w = cvt_pk_bf16(f[6] * rstd * g1[2], f[7] * rstd * g1[3]);
      qr[d0] = *reinterpret_cast<const bf16x8*>(&o); }
    const int t = tok0 + wid * QBLK + r32;
#pragma unroll
    for (int ax = 0; ax < 2; ++ax) {
      const int pos = tok0 < 0 ? 0 : (ax == 0 ? (t >> 6) : (t & 63));
      const u32x4 w1 = *reinterpret_cast<const u32x4*>(&qr[8 + 2 * ax]), w2 = *reinterpret_cast<const u32x4*>(&qr[9 + 2 * ax]);
      float x1[8], x2[8]; x1[0] = bf_lo(w1.x); x1[1] = bf_hi(w1.x); x1[2] = bf_lo(w1.y); x1[3] = bf_hi(w1.y); x1[4] = bf_lo(w1.z); x1[5] = bf_hi(w1.z); x1[6] = bf_lo(w1.w); x1[7] = bf_hi(w1.w);
      x2[0] = bf_lo(w2.x); x2[1] = bf_hi(w2.x); x2[2] = bf_lo(w2.y); x2[3] = bf_hi(w2.y); x2[4] = bf_lo(w2.z); x2[5] = bf_hi(w2.z); x2[6] = bf_lo(w2.w); x2[7] = bf_hi(w2.w);
      float o1[8], o2[8];
#pragma unroll
      for (int e = 0; e < 8; ++e) { const f32x2 cs = tok0 < 0 ? (f32x2){1.f, 0.f} : *(const f32x2*)(rope + ((size_t)pos * 16 + hi * 8 + e) * 2);
        const float y1 = x1[e] * rstd * gq[128 + 32 * ax + hi * 8 + e], y2 = x2[e] * rstd * gq[144 + 32 * ax + hi * 8 + e];
        o1[e] = y1 * cs.x - y2 * cs.y; o2[e] = y1 * cs.y + y2 * cs.x; }
      u32x4 a, b; a.x = cvt_pk_bf16(o1[0], o1[1]); a.y = cvt_pk_bf16(o1[2], o1[3]); a.z = cvt_pk_bf16(o1[4], o1[5]); a.w = cvt_pk_bf16(o1[6], o1[7]);
      b.x = cvt_pk_bf16(o2[0], o2[1]); b.y = cvt_pk_bf16(o2[2], o2[3]); b.z = cvt_pk_bf16(o2[4], o2[5]); b.w = cvt_pk_bf16(o2[6], o2[7]);
      qr[8 + 2 * ax] = *reinterpret_cast<const bf16x8*>(&a); qr[9 + 2 * ax] = *reinterpret_cast<const bf16x8*>(&b); }
  }
  int kb[4];
#pragma unroll
  for (int d = 0; d < 4; ++d) kb[d] = r32 * 384 + (((d * 2 + hi) ^ ((r32 >> 1) & 7)) << 4);
  unsigned kdo[3], vdo[2];
#pragma unroll
  for (int i = 0; i < 3; ++i) { const int byte = ((wid * 3 + i) * 64 + lane) * 16, row = byte / 384, off = byte - row * 384; kdo[i] = (unsigned)(row * (LDK * 2) + (off ^ (((row >> 1) & 7) << 4))); }
#pragma unroll
  for (int i = 0; i < 2; ++i) { const int P = (wid * 2 + i) * 64 + lane, sub = P >> 5, within = P & 31, kk = (sub >> 2) * 8 + (within >> 2), k = (kk & ~0xC) | ((kk & 4) << 1) | ((kk & 8) >> 1), c8 = (sub & 3) * 32 + (within & 3) * 8;
    vdo[i] = (unsigned)(k * (LDV * 2) + c8 * 2); }
  const int vb0 = (int)(uintptr_t)(lds + DMA_VRING) + v_rd_base(lane);
#define KDMA(t, slot) do { const char* g_ = (const char*)Kh + (size_t)(t) * (KVBLK * LDK * 2); _Pragma("unroll") for (int i_ = 0; i_ < 3; ++i_) \
    __builtin_amdgcn_global_load_lds((const unsigned*)(g_ + kdo[i_]), (LAS unsigned*)(ldsl + DMA_KRING + (slot) * SHM_K + (wid * 3 + i_) * 1024), 16, 0, 0); } while (0)
#define VDMA(t, slot) do { const char* g_ = (const char*)Vh + (size_t)(t) * (KVBLK * LDV * 2); _Pragma("unroll") for (int i_ = 0; i_ < 2; ++i_) \
    __builtin_amdgcn_global_load_lds((const unsigned*)(g_ + vdo[i_]), (LAS unsigned*)(ldsl + DMA_VRING + (slot) * SHM_V + (wid * 2 + i_) * 1024), 16, 0, 0); } while (0)
#define NEXT3(s) ((s) == 2 ? 0 : (s) + 1)
#define RESC(a) do { if (__any((a) < 1.f)) { _Pragma("unroll") for (int r = 0; r < 16; ++r) { const float ar_ = __shfl((a), crow(r, hi)); \
    _Pragma("unroll") for (int d = 0; d < 4; ++d) o[d][r] *= ar_; } } } while (0)
#define TOP(t, st) do { if ((t) + 2 < NT) asm volatile("s_waitcnt vmcnt(5)" ::: "memory"); else asm volatile("s_waitcnt vmcnt(0)" ::: "memory"); \
    __builtin_amdgcn_s_barrier(); asm volatile("" ::: "memory"); \
    if ((t) + 2 < NT) KDMA((t) + 2, NEXT3(NEXT3(st))); if ((t) + 1 < NT) VDMA((t) + 1, NEXT3(st)); } while (0)
  f32x16 pA0, pA1, pB0, pB1; bf16x8 pa0, pa1, pa2, pa3; const int NT = seq / KVBLK;
  KDMA(0, 0); VDMA(0, 0); KDMA(1, 1);
  int st = 0;
  TOP(0, st);
  qkt12(pA0, pA1, lds + DMA_KRING + st * SHM_K, qr, kb); partialSM_fix(pA0, pA1);
  for (int j = 1; j + 1 < NT; j += 2) {
    int sp = st; st = NEXT3(st);
    TOP(j, st);
    SBAR(); qkt12(pB0, pB1, lds + DMA_KRING + st * SHM_K, qr, kb);
    finishSM_fix(pA0, pA1, l_reg, pa0, pa1, pa2, pa3); SBAR();
    pv_d0(o, vb0 + sp * SHM_V, pa0, pa1, pa2, pa3); partialSM_fix(pB0, pB1);
    sp = st; st = NEXT3(st);
    TOP(j + 1, st);
    SBAR(); qkt12(pA0, pA1, lds + DMA_KRING + st * SHM_K, qr, kb);
    finishSM_fix(pB0, pB1, l_reg, pa0, pa1, pa2, pa3); SBAR();
    pv_d0(o, vb0 + sp * SHM_V, pa0, pa1, pa2, pa3); partialSM_fix(pA0, pA1);
  }
  { int sp = st; st = NEXT3(st);
    TOP(NT - 1, st);
    SBAR(); qkt12(pB0, pB1, lds + DMA_KRING + st * SHM_K, qr, kb);
    finishSM_fix(pA0, pA1, l_reg, pa0, pa1, pa2, pa3); SBAR();
    pv_d0(o, vb0 + sp * SHM_V, pa0, pa1, pa2, pa3); partialSM_fix(pB0, pB1);
    finishSM_fix(pB0, pB1, l_reg, pa0, pa1, pa2, pa3); SBAR();
    pv_d0(o, vb0 + st * SHM_V, pa0, pa1, pa2, pa3); }
  { auto rr_ = __builtin_amdgcn_permlane32_swap(__float_as_uint(l_reg), __float_as_uint(l_reg), false, false); l_reg = __uint_as_float(rr_[0]) + __uint_as_float(rr_[1]); }
  if (hi == 0) li_l[r32] = l_reg; asm volatile("s_waitcnt vmcnt(0) lgkmcnt(0)" ::: "memory");
  __syncthreads();
  {
    constexpr int RS = 272;
    int tid_e = threadIdx.x; asm volatile("" : "+v"(tid_e));
    const int wid = tid_e >> 6, lane = tid_e & 63, r32 = lane & 31, hi = lane >> 5;
    char* Ost = lds + wid * (32 * RS);
#pragma unroll
    for (int r = 0; r < 16; ++r) { const int rw = crow(r, hi); const float rl = __builtin_amdgcn_rcpf(li_l[rw]);
#pragma unroll
      for (int d0 = 0; d0 < 4; ++d0) *(bf16_t*)(Ost + rw * RS + (d0 * 32 + r32) * 2) = f2bf(o[d0][r] * rl); }
    asm volatile("s_waitcnt lgkmcnt(0)" ::: "memory");
#pragma unroll
    for (int i = 0; i < 8; ++i) { const int q = lane + 64 * i, row = q >> 4, cc = q & 15; const long orow = wid * QBLK + row;
      const u32x4 ov = *(const u32x4*)(Ost + row * RS + cc * 16); const u32x4 gv = *(const u32x4*)(gate + orow * NZ + cc * 8);
      u32x4 w; w.x = cvt_pk_bf16(bf_lo(ov.x) * bf_lo(gv.x), bf_hi(ov.x) * bf_hi(gv.x)); w.y = cvt_pk_bf16(bf_lo(ov.y) * bf_lo(gv.y), bf_hi(ov.y) * bf_hi(gv.y));
      w.z = cvt_pk_bf16(bf_lo(ov.z) * bf_lo(gv.z), bf_hi(ov.z) * bf_hi(gv.z)); w.w = cvt_pk_bf16(bf_lo(ov.w) * bf_lo(gv.w), bf_hi(ov.w) * bf_hi(gv.w));
      *(u32x4*)(Yo + orow * 4096 + cc * 8) = w; }
  }
  __syncthreads();
#undef KDMA
#undef VDMA
#undef NEXT3
#undef RESC
#undef TOP
}
#undef KSWZ
}

#define XB_TMO      128
#define XB_XCNT(j)  (256  + 64 * (j))
#define XB_XSUB(j)  (1280 + 64 * (j))
#define XB_XGEN(j)  (2304 + 64 * (j))
#define XB_TOP      3328
#define XB_TOPGEN   3392
#define XCD_BAR_WORDS 3456
#define XB_SPIN_CAP (1u << 18)
__device__ __forceinline__ unsigned xb_ld(unsigned* p)              { return __hip_atomic_load(p, __ATOMIC_RELAXED, __HIP_MEMORY_SCOPE_AGENT); }
__device__ __forceinline__ unsigned xb_add(unsigned* p, unsigned v) { return __hip_atomic_fetch_add(p, v, __ATOMIC_RELAXED, __HIP_MEMORY_SCOPE_AGENT); }
__device__ __forceinline__ unsigned xb_xcc_id() { return (unsigned)__builtin_amdgcn_s_getreg((3 << 11) | 20) & 0xFu; }
#define XB_SPIN(cond, bar) do { unsigned _sp = 0; while (cond) { __builtin_amdgcn_s_sleep(1); \
    if ((++_sp & 255u) == 0u) { if (xb_ld(&(bar)[XB_TMO])) break; if (_sp > XB_SPIN_CAP) { atomicAdd(&(bar)[XB_TMO], 1u); break; } } } } while (0)
struct XcdBarrier { unsigned* bar; unsigned x; volatile LAS unsigned* st; };
__device__ __forceinline__ XcdBarrier xcd_barrier_post(unsigned* bar, volatile LAS unsigned* st) {
    XcdBarrier b; b.bar = bar; b.x = xb_xcc_id(); b.st = st;
    if (threadIdx.x == 0) (void)xb_add(&bar[XB_XCNT(b.x)], 1u);
    return b;
}
__device__ __forceinline__ void xcd_barrier_complete(unsigned* bar, unsigned x, unsigned& nloc, unsigned& nx) {
    const unsigned G = gridDim.x * gridDim.y * gridDim.z;
    unsigned sum, cnt, mine, sp = 0u;
    for (;;) {
        sum = 0u; cnt = 0u; mine = 0u;
#pragma unroll
        for (unsigned j = 0; j < 16; ++j) { const unsigned c = xb_ld(&bar[XB_XCNT(j)]); sum += c; cnt += (c > 0u) ? 1u : 0u; mine = (j == x) ? c : mine; }
        if (sum == G) break;
        __builtin_amdgcn_s_sleep(1);
        if ((++sp & 255u) == 0u) { if (xb_ld(&bar[XB_TMO])) break; if (sp > XB_SPIN_CAP) { atomicAdd(&bar[XB_TMO], 1u); break; } }
    }
    nloc = mine > 0u ? mine : 1u; nx = cnt > 0u ? cnt : 1u;
}
__device__ __forceinline__ void xcd_barrier(const XcdBarrier& b) {
    asm volatile("s_waitcnt vmcnt(0)" ::: "memory");
    __syncthreads();
    if (threadIdx.x == 0) {
        unsigned* bar = b.bar; asm volatile("" : "+s"(bar));
        __builtin_amdgcn_s_waitcnt(0);
        unsigned bx_ = b.x; asm volatile("" : "+s"(bx_));
        unsigned nloc = b.st[0], nx = b.st[1];
        if (nloc == 0u) { xcd_barrier_complete(bar, bx_, nloc, nx); b.st[0] = nloc; b.st[1] = nx; }
        const unsigned old = xb_add(&bar[XB_XSUB(bx_)], 1u);
        const unsigned gen = old / nloc;
        if (old + 1u == (gen + 1u) * nloc) {
            __builtin_amdgcn_fence(__ATOMIC_RELEASE, "agent");
            asm volatile("s_waitcnt vmcnt(0)" ::: "memory");
            const unsigned og = xb_add(&bar[XB_TOP], 1u);
            const unsigned tg = og / nx;
            if (og + 1u == (tg + 1u) * nx) xb_add(&bar[XB_TOPGEN], 1u);
            else XB_SPIN(xb_ld(&bar[XB_TOPGEN]) == tg, bar);
            __builtin_amdgcn_fence(__ATOMIC_ACQUIRE, "agent");
            xb_add(&bar[XB_XGEN(bx_)], 1u);
            asm volatile("s_waitcnt vmcnt(0)" ::: "memory");
        } else {
            XB_SPIN(xb_ld(&bar[XB_XGEN(bx_)]) == gen, bar);
            __builtin_amdgcn_fence(__ATOMIC_ACQUIRE, "agent");
            asm volatile("s_waitcnt vmcnt(0)" ::: "memory");
        }
    }
    __syncthreads();
}

struct Args {
    const float* in[24]; float* out; unsigned char* ws; int ph_lo, ph_hi;
};

struct Frame {
    LAS unsigned char* lds; char* ldsg;
    int tid, lane, wave, vcu, G, bx;
    const float* const* in; float* out; unsigned char* ws;
};
template <class T> __device__ __forceinline__ T* wsp(const Frame& F, size_t off) { return (T*)(F.ws + off); }

__device__ __forceinline__ void p0_transpose_item(const float* W, int N, bf16_t* WT, int ldt, int k0, int n0, int nrow0, int kcol0, LAS float* scr, int lane) {
#pragma unroll 8
    for (int i = 0; i < 32; ++i) { const int kk = 2 * i + (lane >> 5); scr[kk * 33 + (lane & 31)] = W[(size_t)(k0 + kk) * N + n0 + (lane & 31)]; }
    LDS_WAIT(); asm volatile("" ::: "memory");
    const int c = lane & 7;
#pragma unroll
    for (int j = 0; j < 4; ++j) { const int n = (lane >> 3) + 8 * j; const LAS float* s = scr + (8 * c) * 33 + n;
        u32x4 o; o.x = cvt_pk_bf16(s[0 * 33], s[1 * 33]); o.y = cvt_pk_bf16(s[2 * 33], s[3 * 33]); o.z = cvt_pk_bf16(s[4 * 33], s[5 * 33]); o.w = cvt_pk_bf16(s[6 * 33], s[7 * 33]);
        *(u32x4*)(WT + (size_t)(nrow0 + n) * ldt + kcol0 + k0 + 8 * c) = o; }
    LDS_WAIT(); asm volatile("" ::: "memory");
}
struct TrJob { int in_idx; int K, N; size_t lw_off; int ldt; int kcol0; };
__device__ __forceinline__ void p0_prologue(const Frame& F) {
    {
        LAS float* sv = (LAS float*)(F.lds);
        LAS float* red = (LAS float*)(F.lds + 4096);
        const float* cvec = F.in[1]; const float* cctx = F.in[3];
        float* MOD = wsp<float>(F, WS_MOD);
        for (int it = F.bx; it < 2 * 32 * 24; it += F.G) {
            const int l = it / 768, r = it % 768, kc = r / 24, nb = r % 24;
            const float* W = F.in[5] + (size_t)l * DM * 12288; const float* bias = F.in[6] + (size_t)l * 12288;
            if (F.tid < 384) { const int j = F.tid >> 7, k = kc * 128 + (F.tid & 127); const float v = j < 2 ? cvec[j * DM + k] : cctx[k]; sv[F.tid] = v * sigmoidf_(v); }
            __syncthreads();
            const int cg = F.tid & 127, rs = F.tid >> 7, n = nb * 512 + cg * 4;
            f32x4 a0 = {0.f, 0.f, 0.f, 0.f}, a1 = a0, a2 = a0;
#pragma unroll 8
            for (int i = 0; i < 32; ++i) { const int kk = rs + 4 * i; const f32x4 w = *(const f32x4*)(W + (size_t)(kc * 128 + kk) * 12288 + n);
                a0 += w * sv[kk]; a1 += w * sv[128 + kk]; a2 += w * sv[256 + kk]; }
            *(LAS f32x4*)(red + (rs * 3 + 0) * 512 + cg * 4) = a0; *(LAS f32x4*)(red + (rs * 3 + 1) * 512 + cg * 4) = a1; *(LAS f32x4*)(red + (rs * 3 + 2) * 512 + cg * 4) = a2;
            __syncthreads();
            for (int e = F.tid; e < 1536; e += NTHR) { const int j = e >> 9, col = e & 511;
                float s = red[(0 * 3 + j) * 512 + col] + red[(1 * 3 + j) * 512 + col] + red[(2 * 3 + j) * 512 + col] + red[(3 * 3 + j) * 512 + col];
                if (kc == 0) s += bias[nb * 512 + col];
                atomicAdd(MOD + ((size_t)l * 3 + j) * 12288 + nb * 512 + col, s); }
            __syncthreads();
        }
    }
    const int gw = F.vcu * NWAVES + F.wave, NGW = F.G * NWAVES;
#pragma unroll 1
    for (int rep0 = 0; rep0 < DUP_P0; ++rep0)
    {
        LAS float* scr = (LAS float*)(F.lds + F.wave * 16384);
        const TrJob jobs[9] = { {7, 4096, NIN, LW_IN, 4096, 0}, {9, 768, 3072, LW_UQ, 768, 0}, {11, 512, 4096, LW_UKV, 512, 0}, {14, 1024, 1024, LW_FN, 1024, 0}, {19, 1024, 1024, LW_PW2, 1024, 0},
                                {20, 1024, 4096, LW_BR, 4096, 0}, {21, 2048, 4096, LW_BR, 4096, 1024}, {22, 1024, 4096, LW_BR, 4096, 3072}, {23, 4096, 4096, LW_OUT, 4096, 0} };
        int base = 0;
#pragma unroll
        for (int l = 0; l < NL; ++l)
#pragma unroll
            for (int jb = 0; jb < 9; ++jb) {
                const TrJob J = jobs[jb]; const int nblk = J.N / 32, nitems = (J.K / 64) * nblk;
                const float* W = F.in[J.in_idx] + (size_t)l * J.K * J.N; bf16_t* WT = (bf16_t*)(F.ws + WS_W + (size_t)l * LAYER_W + J.lw_off);
                int first = (gw - base % NGW + NGW) % NGW;
                for (int it = first; it < nitems; it += NGW) { const int kb = it / nblk, nbk = it % nblk, n0 = nbk * 32;
                    const int nrow0 = (jb == 0 && n0 >= 3392) ? n0 + 192 : n0;
                    p0_transpose_item(W, J.N, WT, J.ldt, kb * 64, n0, nrow0, J.kcol0, scr, F.lane); }
                base += nitems;
            }
    }
    const size_t gt = (size_t)F.vcu * NTHR + F.tid, NGT = (size_t)F.G * NTHR;
    for (int l = 0; l < NL; ++l) { u32x4* p = (u32x4*)(F.ws + WS_W + (size_t)l * LAYER_W + LW_IN + (size_t)3392 * DM * 2);
        for (size_t i = gt; i < (size_t)192 * DM * 2 / 16; i += NGT) p[i] = (u32x4){0u, 0u, 0u, 0u}; }
    {
        bf16_t* TAB = wsp<bf16_t>(F, WS_COS);
        for (size_t i = gt; i < (size_t)2048 * 256; i += NGT) { const int k = (int)(i >> 8), s0 = ((int)i & 255) * 8; float ce[8], se[8], co[8], so[8];
#pragma unroll
            for (int j = 0; j < 8; ++j) { const int pe = (2 * k * (s0 + j)) & 8191, po = ((2 * k + 1) * (s0 + j)) & 8191;
                sincospif((float)pe * (1.0f / 4096.0f), &se[j], &ce[j]); sincospif((float)po * (1.0f / 4096.0f), &so[j], &co[j]); }
            const size_t o = (size_t)k * 2048 + s0;
            *(u32x4*)(TAB + o) = pack8(ce); *(u32x4*)(TAB + (size_t)1 * 2048 * 2048 + o) = pack8(co);
            *(u32x4*)(TAB + (size_t)2 * 2048 * 2048 + o) = pack8(se); *(u32x4*)(TAB + (size_t)3 * 2048 * 2048 + o) = pack8(so); }
        bf16_t* CS = wsp<bf16_t>(F, WS_CS);
        for (size_t i = gt; i < (size_t)1024 * 128; i += NGT) { const int m = (int)(i >> 7), c0 = ((int)i & 127) * 8; float cv[8], sv[8];
#pragma unroll
            for (int j = 0; j < 8; ++j) { const int p = (m * (c0 + j)) & 1023; sincospif((float)p * (1.0f / 512.0f), &sv[j], &cv[j]); }
            u32x4 a, b; a.x = cvt_pk_bf16(cv[0], cv[1]); a.y = cvt_pk_bf16(cv[2], cv[3]); a.z = cvt_pk_bf16(cv[4], cv[5]); a.w = cvt_pk_bf16(cv[6], cv[7]);
            b.x = cvt_pk_bf16(sv[0], sv[1]); b.y = cvt_pk_bf16(sv[2], sv[3]); b.z = cvt_pk_bf16(sv[4], sv[5]); b.w = cvt_pk_bf16(sv[6], sv[7]);
            *(u32x4*)(CS + (size_t)m * 1024 + c0) = a; *(u32x4*)(CS + (size_t)(1024 + m) * 1024 + c0) = b; }
        bf16_t* CS256 = wsp<bf16_t>(F, WS_CS256);
        for (size_t i = gt; i < (size_t)256 * 32; i += NGT) { const int k = (int)(i >> 5), s0 = ((int)i & 31) * 8; float cv[8], sv[8];
#pragma unroll
            for (int j = 0; j < 8; ++j) { const int p = (k * (s0 + j)) & 255; sincospif((float)p * (1.0f / 128.0f), &sv[j], &cv[j]); }
            u32x4 a, b; a.x = cvt_pk_bf16(cv[0], cv[1]); a.y = cvt_pk_bf16(cv[2], cv[3]); a.z = cvt_pk_bf16(cv[4], cv[5]); a.w = cvt_pk_bf16(cv[6], cv[7]);
            b.x = cvt_pk_bf16(-sv[0], -sv[1]); b.y = cvt_pk_bf16(-sv[2], -sv[3]); b.z = cvt_pk_bf16(-sv[4], -sv[5]); b.w = cvt_pk_bf16(-sv[6], -sv[7]);
            *(u32x4*)(CS256 + (size_t)k * 512 + s0) = a; *(u32x4*)(CS256 + (size_t)k * 512 + 256 + s0) = b; }
        float* ROPE = wsp<float>(F, WS_ROPE);
        for (size_t i = gt; i < 128 * 16; i += NGT) { const int pos = (int)i >> 4, f = (int)i & 15; const float inv = powf(10000.0f, -(float)f / 16.0f); const float ang = (float)pos * inv;
            float s, c; sincosf(ang, &s, &c); ROPE[i * 2] = c; ROPE[i * 2 + 1] = s; }
    }
}

__device__ __forceinline__ void phase_norm_mod(const Frame& F, int layer, const float* xl, const float* xc) {
    const int gw = F.vcu * NWAVES + F.wave, NGW = F.G * NWAVES;
    bf16_t* H = wsp<bf16_t>(F, WS_H);
    LAS float* GS = (LAS float*)F.lds; LAS float* SH = (LAS float*)(F.lds + 3 * DM * 4);
    { const float* g = F.in[4] + (size_t)layer * DM; const float* mod = wsp<float>(F, WS_MOD) + (size_t)layer * 3 * 12288;
      for (int i = F.tid; i < 3 * (DM / 4); i += NTHR) { const int j = i / (DM / 4), n = (i - j * (DM / 4)) * 4;
          const f32x4 gv = *(const f32x4*)(g + n), sh = *(const f32x4*)(mod + (size_t)j * 12288 + n), sc = *(const f32x4*)(mod + (size_t)j * 12288 + DM + n);
          *(LAS f32x4*)(GS + j * DM + n) = gv * (sc + 1.0f); *(LAS f32x4*)(SH + j * DM + n) = sh; }
      __syncthreads(); }
    for (int m = gw; m < MROWS; m += NGW) {
        const int b = m / SB, p = m - b * SB; const bool isctx = p < CTX;
        const float* src = isctx ? xc + ((size_t)b * CTX + p) * DM : xl + ((size_t)b * SEQ + (p - CTX)) * DM;
        const int jm = isctx ? 2 : b;
        f32x4 v[16]; float ss = 0.f;
#pragma unroll
        for (int j = 0; j < 16; ++j) v[j] = *(const f32x4*)(src + 4 * (F.lane + 64 * j));
        if (isctx && layer > 0) {
            const float* pj = wsp<float>(F, WS_ECOS) + ((size_t)b * CTX + p) * DM;
#pragma unroll 1
            for (int ch = 0; ch < 8; ++ch)
#pragma unroll
                for (int j = 0; j < 16; ++j) v[j] += *(const f32x4*)(pj + (size_t)ch * 512 * DM + 4 * (F.lane + 64 * j)); }
#pragma unroll
        for (int j = 0; j < 16; ++j) ss += (v[j].x * v[j].x + v[j].y * v[j].y) + (v[j].z * v[j].z + v[j].w * v[j].w);
        const float rstd = rsqrtf(wave_sum(ss) * (1.0f / DM) + EPS);
#pragma unroll
        for (int j = 0; j < 16; ++j) { const int n = 4 * (F.lane + 64 * j);
            const f32x4 gs = *(const LAS f32x4*)(GS + jm * DM + n), sh = *(const LAS f32x4*)(SH + jm * DM + n);
            const f32x4 h = v[j] * rstd * gs + sh;
            u32x2 w; w.x = cvt_pk_bf16(h.x, h.y); w.y = cvt_pk_bf16(h.z, h.w); *(u32x2*)(H + (size_t)m * DM + n) = w; }
    }
    __syncthreads();
}


__device__ __forceinline__ void phase_c1_lora_norm(const Frame& F, int layer) {
    const int gw = F.vcu * NWAVES + F.wave, NGW = F.G * NWAVES;
    const bf16_t* Z = wsp<bf16_t>(F, WS_Z); bf16_t* NCQ = wsp<bf16_t>(F, WS_NCQ); bf16_t* NCKV = wsp<bf16_t>(F, WS_NCKV);
    const float* gq = F.in[8] + (size_t)layer * QLORA; const float* gkv = F.in[10] + (size_t)layer * KVLORA;
    for (int m = gw; m < MROWS; m += NGW) {
        const bf16_t* zr = Z + (size_t)m * NZ;
        float a[8], b2[8], c[8]; const bool has2 = F.lane < 32;
        unpack8(*(const u32x4*)(zr + ZC_Q + F.lane * 8), a);
        if (has2) unpack8(*(const u32x4*)(zr + ZC_Q + 512 + F.lane * 8), b2); else {
#pragma unroll
            for (int j = 0; j < 8; ++j) b2[j] = 0.f; }
        unpack8(*(const u32x4*)(zr + ZC_KV + F.lane * 8), c);
        float sq = 0.f, sk = 0.f;
#pragma unroll
        for (int j = 0; j < 8; ++j) { sq += a[j] * a[j] + b2[j] * b2[j]; sk += c[j] * c[j]; }
        const float rq = rsqrtf(wave_sum(sq) * (1.0f / QLORA) + EPS), rk = rsqrtf(wave_sum(sk) * (1.0f / KVLORA) + EPS);
#pragma unroll
        for (int j = 0; j < 8; ++j) { a[j] *= rq * gq[F.lane * 8 + j]; c[j] *= rk * gkv[F.lane * 8 + j]; }
        *(u32x4*)(NCQ + (size_t)m * QLORA + F.lane * 8) = pack8(a);
        *(u32x4*)(NCKV + (size_t)m * KVLORA + F.lane * 8) = pack8(c);
        if (has2) {
#pragma unroll
            for (int j = 0; j < 8; ++j) b2[j] *= rq * gq[512 + F.lane * 8 + j];
            *(u32x4*)(NCQ + (size_t)m * QLORA + 512 + F.lane * 8) = pack8(b2); }
    }
}
__device__ __forceinline__ void phase_c2_fold(const Frame& F, int layer) {
    const bf16_t* Z = wsp<bf16_t>(F, WS_Z); bf16_t* EO = wsp<bf16_t>(F, WS_EO); float* V2 = wsp<float>(F, WS_V2) + (size_t)layer * 2048;
    LAS float* red = (LAS float*)F.lds;
    for (int it = F.bx; it < 256; it += F.G) {
        const int b = it >> 7, ch = it & 127;
        const bf16_t* U = Z + ((size_t)b * SB + CTX) * NZ + ZC_F;
        float v2a[16];
#pragma unroll
        for (int j = 0; j < 16; ++j) v2a[j] = 0.f;
#pragma unroll 1
        for (int i = 0; i < 2; ++i) {
            const int s = ch * 16 + F.wave + 8 * i; const float sg = (s & 1) ? -1.f : 1.f;
#pragma unroll
            for (int hh = 0; hh < 2; ++hh) {
                asm volatile("" ::: "memory");
                const int col = (F.lane + 64 * hh) * 8;
                float x[8], y[8], p[8], q[8], ep[8], em[8], om[8], op[8];
                if (s == 0) { unpack8(*(const u32x4*)(U + col), x); unpack8(*(const u32x4*)(U + (size_t)4096 * NZ + col), y); unpack8(*(const u32x4*)(U + (size_t)2048 * NZ + col), p); unpack8(*(const u32x4*)(U + (size_t)6144 * NZ + col), q);
#pragma unroll
                    for (int j = 0; j < 8; ++j) { ep[j] = x[j]; em[j] = x[j]; om[j] = 0.f; op[j] = 0.f; v2a[hh * 8 + j] += (x[j] + y[j]) + (p[j] + q[j]); } }
                else { unpack8(*(const u32x4*)(U + (size_t)s * NZ + col), x); unpack8(*(const u32x4*)(U + (size_t)(SEQ - s) * NZ + col), y);
                    unpack8(*(const u32x4*)(U + (size_t)(4096 - s) * NZ + col), p); unpack8(*(const u32x4*)(U + (size_t)(4096 + s) * NZ + col), q);
#pragma unroll
                    for (int j = 0; j < 8; ++j) { const float es = x[j] + y[j], emr = p[j] + q[j], os = x[j] - y[j], omr = p[j] - q[j];
                        ep[j] = es + emr; em[j] = es - emr; om[j] = os - omr; op[j] = os + omr; v2a[hh * 8 + j] += sg * ep[j]; } }
                bf16_t* dst = EO + ((size_t)(b * 4) * 2048 + s) * 1024 + col;
                *(u32x4*)(dst) = pack8(ep); *(u32x4*)(dst + (size_t)2048 * 1024) = pack8(em); *(u32x4*)(dst + (size_t)2 * 2048 * 1024) = pack8(om); *(u32x4*)(dst + (size_t)3 * 2048 * 1024) = pack8(op);
            }
        }
#pragma unroll
        for (int hh = 0; hh < 2; ++hh)
#pragma unroll
            for (int j = 0; j < 8; ++j) red[F.wave * 1024 + (F.lane + 64 * hh) * 8 + j] = v2a[hh * 8 + j];
        __syncthreads();
        for (int c = F.tid; c < 1024; c += NTHR) { float sm = 0.f;
#pragma unroll
            for (int w = 0; w < 8; ++w) sm += red[w * 1024 + c];
            atomicAdd(V2 + b * 1024 + c, sm); }
        __syncthreads();
    }
}
__device__ __forceinline__ void phase_c3_conv(const Frame& F, int layer, bool with_ctx) {
    const bf16_t* Z = wsp<bf16_t>(F, WS_Z); bf16_t* CU = wsp<bf16_t>(F, WS_CU);
    const float* cw = F.in[15] + (size_t)layer * CONVW * CD; const float* cb = F.in[16] + (size_t)layer * CD;
    const float* lg = F.in[17] + (size_t)layer * CD; const float* lb = F.in[18] + (size_t)layer * CD;
    LAS float* OUT = (LAS float*)F.lds;
    const int c0 = F.tid * 2;
    float w0[CONVW], w1[CONVW];
#pragma unroll
    for (int j = 0; j < CONVW; ++j) { const f32x2 w = *(const f32x2*)(cw + (size_t)j * CD + c0); w0[j] = w.x; w1[j] = w.y; }
    const f32x2 bias = *(const f32x2*)(cb + c0);
    for (int un = F.bx; un < MROWS / 32; un += F.G) {
        const int m0 = un * 32, b = m0 / SB, p0 = m0 - b * SB; const bool isctx = p0 < CTX;
        if (isctx && !with_ctx) continue;
        const int seq_lo = b * SB + (isctx ? 0 : CTX), seq_hi = b * SB + (isctx ? CTX : SB);
        float S0[CONVW], S1[CONVW];
#pragma unroll
        for (int k = 0; k < CONVW; ++k) { S0[k] = 0.f; S1[k] = 0.f; }
#define CV_LOAD(i, a, g) do { const int row_ = m0 - 15 + (i); if ((i) < 62 && row_ >= seq_lo && row_ < seq_hi) { (a) = *(const unsigned*)(Z + (size_t)row_ * NZ + ZC_GA + c0); (g) = *(const unsigned*)(Z + (size_t)row_ * NZ + ZC_GG + c0); } else { (a) = 0u; (g) = 0u; } } while (0)
#define CV_STEP(i, a, g) do { const float u0_ = bf_lo(a) * bf_lo(g), u1_ = bf_hi(a) * bf_hi(g); \
        _Pragma("unroll") for (int k = CONVW - 1; k >= 1; --k) { S0[k] = fmaf(w0[k], u0_, S0[k - 1]); S1[k] = fmaf(w1[k], u1_, S1[k - 1]); } \
        S0[0] = w0[0] * u0_; S1[0] = w1[0] * u1_; \
        if ((i) >= CONVW - 1 && (i) < 62) *(LAS f32x2*)(OUT + ((i) - (CONVW - 1)) * CD + c0) = (f32x2){S0[CONVW - 1] + bias.x, S1[CONVW - 1] + bias.y}; } while (0)
        unsigned qa0, qa1, qa2, qa3, qg0, qg1, qg2, qg3;
        CV_LOAD(0, qa0, qg0); CV_LOAD(1, qa1, qg1); CV_LOAD(2, qa2, qg2); CV_LOAD(3, qa3, qg3);
#pragma unroll 1
        for (int i0 = 0; i0 < 64; i0 += 4) {
            unsigned na0, na1, na2, na3, ng0, ng1, ng2, ng3;
            CV_LOAD(i0 + 4, na0, ng0); CV_LOAD(i0 + 5, na1, ng1); CV_LOAD(i0 + 6, na2, ng2); CV_LOAD(i0 + 7, na3, ng3);
            CV_STEP(i0, qa0, qg0); CV_STEP(i0 + 1, qa1, qg1); CV_STEP(i0 + 2, qa2, qg2); CV_STEP(i0 + 3, qa3, qg3);
            qa0 = na0; qa1 = na1; qa2 = na2; qa3 = na3; qg0 = ng0; qg1 = ng1; qg2 = ng2; qg3 = ng3;
        }
#undef CV_LOAD
#undef CV_STEP
        __syncthreads();
        {
            f32x4 gam[4], bet[4];
#pragma unroll
            for (int r = 0; r < 4; ++r) { gam[r] = *(const f32x4*)(lg + F.lane * 4 + 256 * r); bet[r] = *(const f32x4*)(lb + F.lane * 4 + 256 * r); }
#pragma unroll 1
            for (int q = 0; q < 4; ++q) { const int tt = F.wave * 4 + q;
                f32x4 x[4]; float sm = 0.f;
#pragma unroll
                for (int r = 0; r < 4; ++r) { x[r] = *(const LAS f32x4*)(OUT + tt * CD + F.lane * 4 + 256 * r); sm += (x[r].x + x[r].y) + (x[r].z + x[r].w); }
                const float mu = wave_sum(sm) * (1.0f / CD); float sq = 0.f;
#pragma unroll
                for (int r = 0; r < 4; ++r) { x[r] = x[r] - mu; sq += (x[r].x * x[r].x + x[r].y * x[r].y) + (x[r].z * x[r].z + x[r].w * x[r].w); }
                const float rs = rsqrtf(wave_sum(sq) * (1.0f / CD) + EPS);
#pragma unroll
                for (int r = 0; r < 4; ++r) { f32x4 y = x[r] * rs * gam[r] + bet[r];
                    y.x *= sigmoidf_(y.x); y.y *= sigmoidf_(y.y); y.z *= sigmoidf_(y.z); y.w *= sigmoidf_(y.w);
                    u32x2 w; w.x = cvt_pk_bf16(y.x, y.y); w.y = cvt_pk_bf16(y.z, y.w);
                    *(u32x2*)(CU + (size_t)(m0 + tt) * CD + F.lane * 4 + 256 * r) = w; }
            }
        }
        __syncthreads();
    }
}
__device__ __forceinline__ void phase_d_specials(const Frame& F, int layer) {
    const bf16_t* Z = wsp<bf16_t>(F, WS_Z); const float* V2 = wsp<float>(F, WS_V2) + (size_t)layer * 2048; float* SPEC = wsp<float>(F, WS_SPEC);
    const bf16_t* CSW = wsp<bf16_t>(F, WS_ZF) + (size_t)layer * 2048 * 1024;
    for (int blk = F.bx; blk < 512; blk += F.G) {
        const int o = blk * 16 + (F.tid >> 5), tl = F.tid & 31;
        const int b = o >> 12, which = (o >> 10) & 3, n = o & 1023;
        const bf16_t* U = Z + ((size_t)b * SB + CTX) * NZ + ZC_F; const bf16_t* T = CSW + (size_t)((which == 3 ? 1024 : 0) + n) * 1024 + tl * 32;
        float sm = 0.f;
#pragma unroll
        for (int q = 0; q < 4; ++q) { float t[8], v[8]; unpack8(*(const u32x4*)(T + q * 8), t); const int c = tl * 32 + q * 8;
            if (which == 0) unpack8(*(const u32x4*)(U + (size_t)4096 * NZ + c), v);
            else if (which == 1) {
#pragma unroll
                for (int j = 0; j < 8; ++j) v[j] = V2[b * 1024 + c + j]; }
            else { float p[8], r[8]; unpack8(*(const u32x4*)(U + (size_t)2048 * NZ + c), p); unpack8(*(const u32x4*)(U + (size_t)6144 * NZ + c), r);
#pragma unroll
                for (int j = 0; j < 8; ++j) v[j] = which == 2 ? p[j] + r[j] : p[j] - r[j]; }
#pragma unroll
            for (int j = 0; j < 8; ++j) sm = fmaf(t[j], v[j], sm); }
        sm += lane_xor<1>(sm); sm += lane_xor<2>(sm); sm += lane_xor<4>(sm); sm += lane_xor<8>(sm); sm += lane_xor<16>(sm);
        if (tl == 0) SPEC[o] = sm;
    }
}
__device__ __forceinline__ void phase_e_finalize(const Frame& F, int layer, bool q_ctx, bool q_too) {
    const int gw = F.vcu * NWAVES + F.wave, NGW = F.G * NWAVES;
    bf16_t* QR = wsp<bf16_t>(F, WS_QR); const bf16_t* KVR = wsp<bf16_t>(F, WS_KVR); bf16_t* KN = wsp<bf16_t>(F, WS_KN); const bf16_t* Z = wsp<bf16_t>(F, WS_Z);
    const float* ROPE = wsp<float>(F, WS_ROPE);
    const float* gq = F.in[12] + (size_t)layer * DQK; const float* gk = F.in[13] + (size_t)layer * DQK;
    const int h = F.lane >> 2, j4 = F.lane & 3;
    const int c1 = (j4 & 1) + 4 * (j4 >> 1), c2 = c1 + 2;
    for (int m = gw; m < MROWS; m += NGW) {
        const int b = m / SB, p = m - b * SB; const bool isctx = p < CTX; const int t = p - CTX;
        const int pos = (j4 < 2) ? (t >> 6) : (t & 63);
        float cs[8], sn[8];
        if (!isctx) {
#pragma unroll
            for (int i = 0; i < 8; ++i) { const f32x2 r = *(const f32x2*)(ROPE + ((size_t)pos * 16 + (j4 & 1) * 8 + i) * 2); cs[i] = r.x; sn[i] = r.y; } }
        else {
#pragma unroll
            for (int i = 0; i < 8; ++i) { cs[i] = 1.f; sn[i] = 0.f; } }
#pragma unroll
        for (int qk = 0; qk < 2; ++qk) {
            if (qk == 0 && (!q_too || (isctx && !q_ctx))) continue;
            const float* gn = qk == 0 ? gq : gk;
            float x[4][8], r1[8], r2[8];
            if (qk == 0) { const bf16_t* src = QR + (size_t)m * 3072 + h * DQK;
#pragma unroll
                for (int cc = 0; cc < 4; ++cc) unpack8(*(const u32x4*)(src + (4 * j4 + cc) * 8), x[cc]);
                unpack8(*(const u32x4*)(src + DNOPE + c1 * 8), r1); unpack8(*(const u32x4*)(src + DNOPE + c2 * 8), r2); }
            else { const bf16_t* src = KVR + (size_t)m * 4096 + h * 256; const bf16_t* rs = Z + (size_t)m * NZ + ZC_KR;
#pragma unroll
                for (int cc = 0; cc < 4; ++cc) unpack8(*(const u32x4*)(src + (4 * j4 + cc) * 8), x[cc]);
                unpack8(*(const u32x4*)(rs + c1 * 8), r1); unpack8(*(const u32x4*)(rs + c2 * 8), r2); }
            float ss = 0.f;
#pragma unroll
            for (int cc = 0; cc < 4; ++cc)
#pragma unroll
                for (int i = 0; i < 8; ++i) ss += x[cc][i] * x[cc][i];
#pragma unroll
            for (int i = 0; i < 8; ++i) ss += r1[i] * r1[i] + r2[i] * r2[i];
            ss += lane_xor<1>(ss); ss += lane_xor<2>(ss);
            const float rstd = rsqrtf(ss * (1.0f / DQK) + EPS);
            bf16_t* dst = (qk == 0 ? QR : KN) + (size_t)m * 3072 + h * DQK;
#pragma unroll
            for (int cc = 0; cc < 4; ++cc) {
#pragma unroll
                for (int i = 0; i < 8; ++i) x[cc][i] *= rstd * gn[(4 * j4 + cc) * 8 + i];
                *(u32x4*)(dst + (4 * j4 + cc) * 8) = pack8(x[cc]); }
            float o1[8], o2[8];
#pragma unroll
            for (int i = 0; i < 8; ++i) { const float y1 = r1[i] * rstd * gn[DNOPE + c1 * 8 + i], y2 = r2[i] * rstd * gn[DNOPE + c2 * 8 + i];
                o1[i] = y1 * cs[i] - y2 * sn[i]; o2[i] = y1 * sn[i] + y2 * cs[i]; }
            *(u32x4*)(dst + DNOPE + c1 * 8) = pack8(o1); *(u32x4*)(dst + DNOPE + c2 * 8) = pack8(o2);
        }
    }
}
__device__ __forceinline__ void phase_g_combine(const Frame& F) {
    const size_t gt = (size_t)F.vcu * NTHR + F.tid, NGT = (size_t)F.G * NTHR;
    const float* G12 = wsp<float>(F, WS_G12); const float* SPEC = wsp<float>(F, WS_SPEC); bf16_t* Y = wsp<bf16_t>(F, WS_Y); const bf16_t* Z = wsp<bf16_t>(F, WS_Z);
    const float sc = 0.00034526698300124393f;
    for (size_t i = gt; i < (size_t)2 * 2048 * 128; i += NGT) {
        const int b = (int)(i >> 18), kp = (int)(i >> 7) & 2047, m0 = ((int)i & 127) * 8; const float sg = (kp & 1) ? -1.f : 1.f;
        const float* g = G12 + ((size_t)(b * 4) * 2048 + kp) * 1024 + m0; const size_t js = (size_t)2048 * 1024;
        const float* sp = SPEC + (size_t)(b * 4) * 1024 + m0;
        float e0[8], e1[8], o0[8], o1[8];
#pragma unroll
        for (int hh = 0; hh < 2; ++hh) { const f32x4 g1e = *(const f32x4*)(g + 4 * hh), g1o = *(const f32x4*)(g + js + 4 * hh), g2e = *(const f32x4*)(g + 2 * js + 4 * hh), g2o = *(const f32x4*)(g + 3 * js + 4 * hh);
            const f32x4 E4 = *(const f32x4*)(sp + 4 * hh), E2 = *(const f32x4*)(sp + 2048 + 4 * hh), O2 = *(const f32x4*)(sp + 3072 + 4 * hh);
#pragma unroll
            for (int j = 0; j < 4; ++j) { const float a1 = g1e[j] + sg * E2[j] + E4[j], a2 = g2e[j]; e0[hh * 4 + j] = (a1 - a2) * sc; e1[hh * 4 + j] = (a1 + a2) * sc;
                const float b1 = g1o[j] - E4[j], b2v = g2o[j] + sg * O2[j]; o0[hh * 4 + j] = (b1 - b2v) * sc; o1[hh * 4 + j] = (b1 + b2v) * sc; } }
        const size_t row0 = (size_t)b * SB + CTX; const int k = 2 * kp;
#define YF_STORE(krow, arr) do { const size_t r_ = row0 + (size_t)(krow); float g_[8], o_[8]; unpack8(*(const u32x4*)(Z + r_ * NZ + ZC_FG + m0), g_); \
            _Pragma("unroll") for (int j = 0; j < 8; ++j) o_[j] = (arr)[j] * g_[j]; *(u32x4*)(Y + r_ * 4096 + m0) = pack8(o_); } while (0)
        YF_STORE(k, e0); YF_STORE(k + 1, o0); YF_STORE(SEQ - k - 1, o1);
        if (kp >= 1) YF_STORE(SEQ - k, e1);
        else { const float* zp = SPEC + (size_t)(b * 4 + 1) * 1024 + m0; float z[8];
#pragma unroll
            for (int j = 0; j < 8; ++j) z[j] = zp[j] * sc;
            YF_STORE(4096, z); }
#undef YF_STORE
    }
}

__device__ __forceinline__ bool att_needs_fallback(const float* gq, const float* gk, int lane) {
    float a = fmaxf(fmaxf(fabsf(gq[lane]), fabsf(gq[64 + lane])), fabsf(gq[128 + lane])), b2 = fmaxf(fmaxf(fabsf(gk[lane]), fabsf(gk[64 + lane])), fabsf(gk[128 + lane]));
    a = fmaxf(a, lane_xor<1>(a)); a = fmaxf(a, lane_xor<2>(a)); a = fmaxf(a, lane_xor<4>(a)); a = fmaxf(a, lane_xor<8>(a)); a = fmaxf(a, lane_xor<16>(a)); a = fmaxf(a, lane_xor<32>(a));
    b2 = fmaxf(b2, lane_xor<1>(b2)); b2 = fmaxf(b2, lane_xor<2>(b2)); b2 = fmaxf(b2, lane_xor<4>(b2)); b2 = fmaxf(b2, lane_xor<8>(b2)); b2 = fmaxf(b2, lane_xor<16>(b2)); b2 = fmaxf(b2, lane_xor<32>(b2));
    const float bound = (192.0f * a * b2) * (att::SCALE * 1.4426950408889634f);
    return !(bound <= 100.0f);
}
constexpr int NPH = 1 + 10 * NL;
__global__ void __launch_bounds__(NTHR, 2) fwd_kernel(Args args) {
    extern __shared__ __attribute__((aligned(16))) unsigned char lds_raw[];
    Frame F;
    F.lds = (LAS unsigned char*)lds_raw; F.ldsg = (char*)lds_raw;
    F.tid = threadIdx.x; F.lane = F.tid & 63; F.wave = __builtin_amdgcn_readfirstlane(F.tid >> 6);
    F.G = gridDim.x; F.bx = blockIdx.x; F.vcu = (F.G % 8 == 0) ? (F.bx % 8) * (F.G / 8) + F.bx / 8 : F.bx;
    F.in = args.in; F.out = args.out; F.ws = args.ws;
    volatile LAS unsigned* MISC = (volatile LAS unsigned*)(F.lds + MISC_OFF);
    for (int u = F.tid; u < (LDS_BYTES - LDSCTL_OFF) / 4; u += NTHR) ((LAS unsigned*)(F.lds + LDSCTL_OFF))[u] = 0u;
    __syncthreads();
    unsigned* barw = (unsigned*)(F.ws + WS_CTL) + CW_BAR;
    XcdBarrier bar; bar.bar = barw; bar.x = 0; bar.st = nullptr;
#if !MK_PER_PHASE
    bar = xcd_barrier_post(barw, MISC + 8);
#define GRID_BAR() xcd_barrier(bar)
#else
    (void)MISC;
#define GRID_BAR() do { } while (0)
#endif
    const int lo = args.ph_lo, hi = args.ph_hi;
#define IN(k) (lo <= (k) && (k) < hi)
#define REFRESH() do { F.tid = tid_fresh(); F.lane = F.tid & 63; F.wave = __builtin_amdgcn_readfirstlane(F.tid >> 6); { unsigned char* w_ = F.ws; asm volatile("" : "+s"(w_)); F.ws = w_; } \
    { int g_ = F.G, b_ = F.bx, v_ = F.vcu; asm volatile("" : "+s"(g_), "+s"(b_), "+s"(v_)); F.G = g_; F.bx = b_; F.vcu = v_; G = g_; bx = b_; wsb = (const char*)F.ws; } } while (0)
#ifdef ONLY_J
#define INJ(j) ((j) == ONLY_J && IN(P + (j)))
#define IN0 (ONLY_J == -1 && IN(0))
#else
#define INJ(j) IN(P + (j))
#define IN0 IN(0)
#endif
#define SEAM(k) do { if (IN(k) && IN((k) + 1)) GRID_BAR(); } while (0)
    int G = F.G, bx = F.bx;
    const char* wsb = (const char*)F.ws;

    if (IN0) { REFRESH(); p0_prologue(F); } SEAM(0);

#pragma unroll 1
    for (int l = 0; l < NL; ++l) {
        const int P = 1 + 10 * l; const bool full = (l == 0);
        const unsigned char* LW = F.ws + WS_W + (size_t)l * LAYER_W;
        const float* MODL = wsp<float>(F, WS_MOD) + (size_t)l * 3 * 12288;
        if (INJ(0)) { for (int rep = 0; rep < DUP_EW; ++rep) { if (rep) GRID_BAR(); REFRESH(); phase_norm_mod(F, l, l == 0 ? F.in[0] : F.out, F.in[2]); } } SEAM(P + 0);
        if (INJ(1)) {
#pragma unroll 1
          for (int rep = 0; rep < DUP_B; ++rep) {
            if (rep) GRID_BAR();
            REFRESH();
            pg8::EpiZ E{wsp<bf16_t>(F, WS_Z)};
            { pg8::TileSched S; S.init(wsb + WS_H, DM, LW + LW_IN, DM, DM, full ? 0 : 1, 82, 0, G, bx); pg8::gemm_phase(F.lds, S, E, DM, DM); }
            {
              pg8::EpiBf16 Ec{wsp<bf16_t>(F, WS_ZF) + (size_t)l * 2048 * 1024, 1024, 1.0f}; pg8::CswSched Sc{(const char*)(LW + LW_FN), wsb + WS_CS, G, (bx + G - (full ? 40 : 136) % G) % G}; pg8::gemm_phase(F.lds, Sc, Ec, 1024, 1024); }
            if (!full) {
                pg8::TileSched S2; S2.init(wsb + WS_H, DM, LW + LW_IN + (size_t)ZC_KV * DM * 2, DM, DM, 2, 3, ZC_KV, G, (bx + G - (64 * 82) % G) % G); pg8::gemm_phase(F.lds, S2, E, DM, DM); }
          }
        } SEAM(P + 1);
        if (INJ(2)) { for (int rep = 0; rep < DUP_EW; ++rep) { if (rep) GRID_BAR(); REFRESH(); phase_c1_lora_norm(F, l); if (!rep) { REFRESH(); phase_c2_fold(F, l); } REFRESH(); phase_c3_conv(F, l, full); } } SEAM(P + 2);
        if (INJ(3)) {
#pragma unroll 1
          for (int rep = 0; rep < DUP_GS; ++rep) {
            if (rep) GRID_BAR();
            REFRESH(); phase_d_specials(F, l);
            int rot = 0;
            { pg8::EpiBf16 E{wsp<bf16_t>(F, WS_KVR), 4096, 1.0f}; pg8::TileSched S; S.init(wsb + WS_NCKV, KVLORA, LW + LW_UKV, KVLORA, KVLORA, 0, 16, 0, G, bx); pg8::gemm_phase(F.lds, S, E, KVLORA, KVLORA); rot += S.units(); }
            { pg8::EpiBf16 E{wsp<bf16_t>(F, WS_QR), 3072, 1.0f}; pg8::TileSched S; S.init(wsb + WS_NCQ, QLORA, LW + LW_UQ, QLORA, QLORA, full ? 0 : 1, 12, 0, G, (bx + G - rot % G) % G); pg8::gemm_phase(F.lds, S, E, QLORA, QLORA); rot += S.units(); }
            { pg8::EpiGate E{wsp<bf16_t>(F, WS_Y), wsp<bf16_t>(F, WS_Z), 3072, ZC_CG, 1.0f}; pg8::TileSched S; S.init(wsb + WS_CU, CD, LW + LW_PW2, CD, CD, full ? 0 : 1, 4, 0, G, (bx + G - rot % G) % G); pg8::gemm_phase(F.lds, S, E, CD, CD); rot += S.units(); }
            const char* CSWl = wsb + WS_ZF + (size_t)l * 2048 * 1024 * 2;
            { pg8::EpiBf16 E{wsp<bf16_t>(F, WS_ECOS), 16384, 1.0f}; pg8::FchanSched S{CSWl, wsb + WS_EO, G, (bx + G - rot % G) % G}; pg8::gemm_phase(F.lds, S, E, 1024, 1024); rot += 256; }
            if (full) { pg8::EpiBf16 E{wsp<bf16_t>(F, WS_TCT), 512, 1.0f}; pg8::FchanCtxSched S{CSWl, wsb + WS_Z, G, (bx + G - rot % G) % G}; pg8::gemm_phase(F.lds, S, E, 1024, NZ); }
          }
        } SEAM(P + 3);
        if (INJ(4)) { REFRESH(); const bool fb = att_needs_fallback(F.in[12] + (size_t)l * DQK, F.in[13] + (size_t)l * DQK, F.lane); phase_e_finalize(F, l, full, fb); } SEAM(P + 4);
        if (INJ(5)) {
#pragma unroll 1
          for (int rep = 0; rep < DUP_F; ++rep) {
            if (rep) GRID_BAR();
            REFRESH();
            const bf16_t* QR = wsp<bf16_t>(F, WS_QR); const bf16_t* KN = wsp<bf16_t>(F, WS_KN); const bf16_t* KVR = wsp<bf16_t>(F, WS_KVR); const bf16_t* Z = wsp<bf16_t>(F, WS_Z); bf16_t* Y = wsp<bf16_t>(F, WS_Y);
            const int nun = 1024 + (full ? 32 : 0); const bool fb = att_needs_fallback(F.in[12] + (size_t)l * DQK, F.in[13] + (size_t)l * DQK, F.tid & 63);
#define ATT_UNIT_DECODE() \
                const int L = i * G + bx; if (L >= nun) break; \
                int bh, qb = 0, seq; size_t qrow; \
                if (L < 1024) { const int rnd = L / 256, w = L % 256; bh = rnd * 8 + (w & 7); qb = w >> 3; seq = SB; qrow = (size_t)(bh >> 4) * SB + CTX + (size_t)qb * 256; } \
                else { bh = L - 1024; seq = CTX; qrow = (size_t)(bh >> 4) * SB; } \
                const int b = bh >> 4, h = bh & 15; const size_t krow = (size_t)b * SB;
            if (__builtin_expect(!fb, 1)) {
                for (int i = 0;; ++i) { ATT_UNIT_DECODE()
                    att::attn_unit_dma(QR + qrow * 3072 + h * DQK, KN + krow * 3072 + h * DQK, KVR + krow * 4096 + h * 256 + 128, seq, F.ldsg, F.lds,
                               Z + qrow * NZ + ZC_MG + h * 128, Y + qrow * 4096 + 1024 + h * 128, F.in[12] + (size_t)l * DQK, wsp<float>(F, WS_ROPE), L < 1024 ? qb * 256 : -1); }
            } else {
                for (int i = 0;; ++i) { ATT_UNIT_DECODE()
                    att::attn_unit(QR + qrow * 3072 + h * DQK, KN + krow * 3072 + h * DQK, KVR + krow * 4096 + h * 256 + 128, seq, F.ldsg,
                               Z + qrow * NZ + ZC_MG + h * 128, Y + qrow * 4096 + 1024 + h * 128); }
            }
#undef ATT_UNIT_DECODE
            __syncthreads();
#ifndef NO_F2
            { pg8::EpiF32 E{wsp<float>(F, WS_G12), 1024}; pg8::FseqSched S{wsb, G, bx}; pg8::gemm_phase(F.lds, S, E, 2048, 16384); }
            if (full) { pg8::EpiGate E{wsp<bf16_t>(F, WS_Y), wsp<bf16_t>(F, WS_Z), 0, ZC_FG, 0.001953125f}; pg8::FseqCtxSched S{wsb + WS_CS256, wsb + WS_TCT, G, (bx + G - 32) % G}; pg8::gemm_phase(F.lds, S, E, 512, 512); }
#endif
          }
        } SEAM(P + 5);
        if (INJ(6)) { for (int rep = 0; rep < DUP_EW; ++rep) { if (rep) GRID_BAR(); REFRESH(); phase_g_combine(F); } } SEAM(P + 6);
        if (INJ(8)) { for (int rep = 0; rep < DUP_GS; ++rep) { if (rep) GRID_BAR(); REFRESH(); pg8::EpiMerge E{wsp<bf16_t>(F, WS_MRG), wsp<bf16_t>(F, WS_Z)}; pg8::MergeSched S{wsb + WS_Y, (const char*)(LW + LW_BR), 1, 64, G, bx}; pg8::gemm_phase(F.lds, S, E, 4096, 4096); }
            if (full) {
                pg8::EpiMergePart E{wsp<float>(F, WS_G12), wsp<bf16_t>(F, WS_Z)}; pg8::CtxSplitSched S{wsb + WS_Y, (const char*)(LW + LW_BR), 1, G, bx}; pg8::gemm_phase(F.lds, S, E, 4096, 4096); }
        } SEAM(P + 8);
        if (INJ(9)) {
            REFRESH();
            if (full) {
                REFRESH();
                const size_t gt = (size_t)F.vcu * NTHR + F.tid, NGT = (size_t)F.G * NTHR; const float* PI = wsp<float>(F, WS_G12); bf16_t* MR = wsp<bf16_t>(F, WS_MRG);
                for (size_t i = gt; i < (size_t)512 * 512; i += NGT) { const int r = (int)(i >> 9), c8 = ((int)i & 511) * 8; float a[8];
#pragma unroll
                    for (int j = 0; j < 8; ++j) a[j] = 0.f;
#pragma unroll 1
                    for (int ch = 0; ch < 8; ++ch) { const f32x4 x0 = *(const f32x4*)(PI + ((size_t)ch * 512 + r) * 4096 + c8), x1 = *(const f32x4*)(PI + ((size_t)ch * 512 + r) * 4096 + c8 + 4);
                        a[0] += x0[0]; a[1] += x0[1]; a[2] += x0[2]; a[3] += x0[3]; a[4] += x1[0]; a[5] += x1[1]; a[6] += x1[2]; a[7] += x1[3]; }
                    const size_t m = (size_t)(r >> 8) * SB + (r & 255);
                    *(u32x4*)(MR + m * 4096 + c8) = pack8(a); }
                GRID_BAR();
            }
            pg8::EpiOut E{l == 0 ? F.in[0] : F.out, F.in[2], F.out, wsp<float>(F, WS_XC1), MODL};
            pg8::TileSched S; S.init(wsb + WS_MRG, DM, LW + LW_OUT, DM, DM, 1, 16, 0, G, bx); pg8::gemm_phase(F.lds, S, E, DM, DM);
            if (full) { pg8::EpiOutPart E2{wsp<float>(F, WS_ECOS), MODL}; pg8::CtxSplitSched S2{wsb + WS_MRG, (const char*)(LW + LW_OUT), 0, G, bx}; pg8::gemm_phase(F.lds, S2, E2, 4096, 4096); }
        } SEAM(P + 9);
    }
#undef IN
#undef SEAM
#undef GRID_BAR
}

extern "C" void kernel_launch(void* const* d_in, const int* in_sizes, int n_in, void* d_out, int out_size, void* d_ws, size_t ws_size, hipStream_t stream) {
    static int grid = 0;
    if (grid == 0) {
        if (n_in != 24 || out_size != NB * SEQ * DM || ws_size < WS_END) { fprintf(stderr, "kernel_launch: unexpected shapes: n_in %d out %d ws %zu (need %zu)\n", n_in, out_size, ws_size, (size_t)WS_END); grid = -1; return; }
        int dev = 0, cus = 0, per_cu = 0;
        if (hipGetDevice(&dev) != hipSuccess || hipDeviceGetAttribute(&cus, hipDeviceAttributeMultiprocessorCount, dev) != hipSuccess) { grid = -1; return; }
        if (hipFuncSetAttribute((const void*)fwd_kernel, hipFuncAttributeMaxDynamicSharedMemorySize, LDS_BYTES) != hipSuccess) { fprintf(stderr, "kernel_launch: hipFuncSetAttribute failed\n"); grid = -1; return; }
        if (hipOccupancyMaxActiveBlocksPerMultiprocessor(&per_cu, (const void*)fwd_kernel, NTHR, LDS_BYTES) != hipSuccess || per_cu < 1) fprintf(stderr, "kernel_launch: occupancy query says %d\n", per_cu);
        (void)hipGetLastError();
        grid = cus;
    }
    if (grid < 0) return;
    (void)hipMemsetAsync((char*)d_ws + WS_CTL, 0, ZERO_BYTES, stream);
    Args a{};
    for (int i = 0; i < 24; ++i) a.in[i] = (const float*)d_in[i];
    a.out = (float*)d_out; a.ws = (unsigned char*)d_ws;
#if MK_PER_PHASE
    for (int p = 0; p < NPH; ++p) { a.ph_lo = p; a.ph_hi = p + 1; hipLaunchKernelGGL(fwd_kernel, dim3(grid), dim3(NTHR), LDS_BYTES, stream, a); }
#else
    a.ph_lo = 0; a.ph_hi = NPH; hipLaunchKernelGGL(fwd_kernel, dim3(grid), dim3(NTHR), LDS_BYTES, stream, a);
#endif
    const hipError_t le = hipPeekAtLastError();
    if (le != hipSuccess) fprintf(stderr, "kernel_launch: launch failed: %s\n", hipGetErrorName(le));
}
```
